# Optimizing an MI355X kernel written in HIP

```python
import math
import jax, jax.numpy as jnp
from jax import lax
import numpy as np

D_MODEL = 1024
BATCH = 16
SEQ = 2048
DEPTH = 1

MIX_WIDTH = D_MODEL
GLA_HEADS = 4
GLA_WIDTH = MIX_WIDTH // 2
GLA_DV = GLA_WIDTH // GLA_HEADS
GLA_DK = GLA_DV // 2
GLA_RANK = 16
GLA_TAU = 16.0
HG_HEADS = 4
HG_WIDTH = MIX_WIDTH - GLA_WIDTH
HG_DK = HG_WIDTH // HG_HEADS
HG_DV = HG_DK
CHUNK = 64
IN_SIZES = (GLA_HEADS * GLA_DK, GLA_HEADS * GLA_DK, GLA_WIDTH, GLA_WIDTH, GLA_RANK,
            HG_WIDTH, HG_WIDTH, HG_WIDTH, HG_WIDTH)
IN_COLS = GLA_HEADS * GLA_DK * 2 + GLA_WIDTH * 2 + GLA_RANK + HG_WIDTH * 4
N_GROUPS = 4
EXPERTS_PER_GROUP = 8
N_EXPERTS = N_GROUPS * EXPERTS_PER_GROUP
EXPERT_FF = D_MODEL // 4
TOP_K = 2
EPS = 1e-6

kernel_name = "hymba_gla_hgrn2_hmoe_adaln"


def rmsnorm(x, g):
    xf = x.astype(jnp.float32)
    r = lax.rsqrt(jnp.mean(xf * xf, axis=-1, keepdims=True) + EPS)
    return xf * r * g.astype(jnp.float32)


def modulate(hf, shift, scale, dtype):
    return (hf * (1.0 + scale[:, None, :].astype(jnp.float32)) + shift[:, None, :].astype(jnp.float32)).astype(dtype)


def chunk_gated_linear_attention(q, k, v, log_g):
    B, S, H, dk = q.shape
    dv = v.shape[-1]
    nc = S // CHUNK

    def to_chunks(t):
        return t.astype(jnp.float32).reshape(B, nc, CHUNK, H, t.shape[-1]).transpose(1, 0, 3, 2, 4)

    causal = jnp.tril(jnp.ones((CHUNK, CHUNK), dtype=bool))

    def step(state, inp):
        qc, kc, vc, gc = inp
        b = jnp.cumsum(gc, axis=2)
        diff = jnp.where(causal[:, :, None], b[:, :, :, None, :] - b[:, :, None, :, :], -jnp.inf)
        attn = jnp.sum(qc[:, :, :, None, :] * kc[:, :, None, :, :] * jnp.exp(diff), axis=-1)
        o = jnp.einsum('bhij,bhjv->bhiv', attn, vc) + jnp.einsum('bhik,bhkv->bhiv', qc * jnp.exp(b), state)
        b_last = b[:, :, -1:, :]
        state = jnp.exp(b_last[:, :, 0, :])[..., None] * state + jnp.einsum(
            'bhjk,bhjv->bhkv', kc * jnp.exp(b_last - b), vc)
        return state, o

    s0 = jnp.zeros((B, H, dk, dv), jnp.float32)
    _, o = lax.scan(step, s0, (to_chunks(q), to_chunks(k), to_chunks(v), to_chunks(log_g)))
    return o.transpose(1, 0, 3, 2, 4).reshape(B, S, H, dv)


def head_rmsnorm(o, g):
    r = lax.rsqrt(jnp.mean(o * o, axis=-1, keepdims=True) + EPS)
    return o * r * g.astype(jnp.float32)


def hybrid_mixer(h, w_in, gla_w_a2, gla_b_a, gla_norm_g, hg_norm_g, lb, w_out):
    B, S, _ = h.shape
    proj = h @ w_in
    offs = []
    acc = 0
    for s in IN_SIZES[:-1]:
        acc += s
        offs.append(acc)
    gq, gk, gv, gg, ga, hq, hf, hi, hg = jnp.split(proj, offs, axis=-1)

    q = gq.reshape(B, S, GLA_HEADS, GLA_DK).astype(jnp.float32) * (GLA_DK ** -0.5)
    k = gk.reshape(B, S, GLA_HEADS, GLA_DK)
    v = gv.reshape(B, S, GLA_HEADS, GLA_DV)
    a_logit = (ga @ gla_w_a2 + gla_b_a).astype(jnp.float32)
    log_alpha = (jax.nn.log_sigmoid(a_logit) / GLA_TAU).reshape(B, S, GLA_HEADS, GLA_DK)
    o_a = chunk_gated_linear_attention(q, k, v, log_alpha)
    o_a = head_rmsnorm(o_a, gla_norm_g) * jax.nn.silu(gg.astype(jnp.float32)).reshape(B, S, GLA_HEADS, GLA_DV)
    o_a = o_a.reshape(B, S, GLA_WIDTH)

    f = lb + (1.0 - lb) * jax.nn.sigmoid(hf.astype(jnp.float32))
    k_h = (1.0 - f).reshape(B, S, HG_HEADS, HG_DK)
    log_f = jnp.log(f).reshape(B, S, HG_HEADS, HG_DK)
    q_h = hq.reshape(B, S, HG_HEADS, HG_DK).astype(jnp.float32) * (HG_DK ** -0.5)
    i_h = hi.reshape(B, S, HG_HEADS, HG_DV)
    o_b = chunk_gated_linear_attention(q_h, k_h, i_h, log_f)
    o_b = head_rmsnorm(o_b, hg_norm_g) * jax.nn.silu(hg.astype(jnp.float32)).reshape(B, S, HG_HEADS, HG_DV)
    o_b = o_b.reshape(B, S, HG_WIDTH)

    o = jnp.concatenate([o_a, o_b], axis=-1).astype(h.dtype)
    return o @ w_out


def hierarchical_moe(h, w_rg, b_rg, w_re, b_re, w_gate, w_up, w_down):
    B, S, D = h.shape
    hf = h.reshape(B * S, D)
    g_probs = jax.nn.softmax((hf @ w_rg + b_rg).astype(jnp.float32), axis=-1)
    g_p, g_idx = lax.top_k(g_probs, 1)
    e_logits = (hf @ w_re + b_re).astype(jnp.float32).reshape(B * S, N_GROUPS, EXPERTS_PER_GROUP)
    sel = jnp.take_along_axis(e_logits, g_idx[:, :, None], axis=1)[:, 0]
    e_probs = jax.nn.softmax(sel, axis=-1)
    e_p, e_idx = lax.top_k(e_probs, TOP_K)
    e_p = e_p / jnp.sum(e_p, axis=-1, keepdims=True)
    weights = g_p * e_p
    expert_ids = g_idx * EXPERTS_PER_GROUP + e_idx
    combine = jnp.sum(jax.nn.one_hot(expert_ids, N_EXPERTS, dtype=jnp.float32) * weights[..., None], axis=1)
    combine = combine.reshape(B, S, N_EXPERTS).astype(h.dtype)

    def per_sequence(args):
        xs, cw = args
        a = jax.nn.silu(jnp.einsum('sd,edf->sef', xs, w_gate)) * jnp.einsum('sd,edf->sef', xs, w_up)
        return jnp.einsum('sef,efd->sd', a * cw[..., None], w_down)

    return lax.map(per_sequence, (h, combine))


def setup_inputs(seed: int = 0) -> dict:
    key = jax.random.key(seed)
    ks = jax.random.split(key, 24)
    f32 = jnp.float32

    def nrm(k, shape, fan_in, mult=1.0):
        return jax.random.normal(k, shape, f32) * (mult * fan_in ** -0.5)

    L, D = DEPTH, D_MODEL
    return {
        "x": jax.random.normal(ks[0], (BATCH, SEQ, D), f32),
        "c": jax.random.normal(ks[1], (BATCH, D), f32),
        "w_ada": nrm(ks[2], (L, D, 6 * D), D, 0.5),
        "b_ada": 0.02 * jax.random.normal(ks[3], (L, 6 * D), f32),
        "norm1_g": 1.0 + 0.02 * jax.random.normal(ks[4], (L, D), f32),
        "w_in": nrm(ks[5], (L, D, IN_COLS), D),
        "gla_w_a2": nrm(ks[6], (L, GLA_RANK, GLA_HEADS * GLA_DK), GLA_RANK),
        "gla_b_a": 0.1 * jax.random.normal(ks[7], (L, GLA_HEADS * GLA_DK), f32),
        "gla_norm_g": 1.0 + 0.02 * jax.random.normal(ks[8], (L, GLA_DV), f32),
        "hg_norm_g": 1.0 + 0.02 * jax.random.normal(ks[9], (L, HG_DV), f32),
        "hg_lb_logits": 0.1 * jax.random.normal(ks[10], (L + 1, HG_WIDTH), f32),
        "w_out": nrm(ks[11], (L, MIX_WIDTH, D), MIX_WIDTH),
        "norm2_g": 1.0 + 0.02 * jax.random.normal(ks[12], (L, D), f32),
        "w_rg": nrm(ks[13], (L, D, N_GROUPS), D),
        "b_rg": 0.01 * jax.random.normal(ks[14], (L, N_GROUPS), f32),
        "w_re": nrm(ks[15], (L, D, N_EXPERTS), D),
        "b_re": 0.01 * jax.random.normal(ks[16], (L, N_EXPERTS), f32),
        "w_exp_gate": nrm(ks[17], (L, N_EXPERTS, D, EXPERT_FF), D),
        "w_exp_up": nrm(ks[18], (L, N_EXPERTS, D, EXPERT_FF), D),
        "w_exp_down": nrm(ks[19], (L, N_EXPERTS, EXPERT_FF, D), EXPERT_FF),
        "w_ada_final": nrm(ks[20], (D, 2 * D), D, 0.5),
        "b_ada_final": 0.02 * jax.random.normal(ks[21], (2 * D,), f32),
        "norm_f_g": 1.0 + 0.02 * jax.random.normal(ks[22], (D,), f32),
    }


def reference(x, c, w_ada, b_ada, norm1_g, w_in, gla_w_a2, gla_b_a, gla_norm_g, hg_norm_g,
              hg_lb_logits, w_out, norm2_g, w_rg, b_rg, w_re, b_re, w_exp_gate, w_exp_up,
              w_exp_down, w_ada_final, b_ada_final, norm_f_g):
    dt = x.dtype
    c_act = jax.nn.silu(c)
    lb_all = jnp.cumsum(jax.nn.softmax(hg_lb_logits.astype(jnp.float32), axis=0), axis=0)
    for l in range(DEPTH):
        mod = c_act @ w_ada[l] + b_ada[l]
        sh1, sc1, gt1, sh2, sc2, gt2 = jnp.split(mod, 6, axis=-1)
        h = modulate(rmsnorm(x, norm1_g[l]), sh1, sc1, dt)
        mix = hybrid_mixer(h, w_in[l], gla_w_a2[l], gla_b_a[l], gla_norm_g[l], hg_norm_g[l],
                           lb_all[l], w_out[l])
        x = x + gt1[:, None, :] * mix
        h2 = modulate(rmsnorm(x, norm2_g[l]), sh2, sc2, dt)
        ffn = hierarchical_moe(h2, w_rg[l], b_rg[l], w_re[l], b_re[l],
                               w_exp_gate[l], w_exp_up[l], w_exp_down[l])
        x = x + gt2[:, None, :] * ffn
    mod_f = c_act @ w_ada_final + b_ada_final
    sh_f, sc_f = jnp.split(mod_f, 2, axis=-1)
    return modulate(rmsnorm(x, norm_f_g), sh_f, sc_f, dt)
```

```cpp
#include <hip/hip_runtime.h>
#include <cstdio>
#include <cstdint>

#define GAS __attribute__((address_space(1)))
#define LAS __attribute__((address_space(3)))
typedef unsigned short bf16;
typedef unsigned v4u __attribute__((ext_vector_type(4)));
typedef unsigned v2u __attribute__((ext_vector_type(2)));
typedef float f32x4 __attribute__((ext_vector_type(4)));

constexpr int NB = 16, SEQ = 2048, D = 1024, M = NB * SEQ;
constexpr int IN_COLS = 3600;
constexpr int NP = 3840;
constexpr int C_GQ = 0, C_GK = 256, C_GV = 512, C_GG = 1024, C_HQ = 1536, C_HF = 2048, C_HI = 2560, C_HG = 3072, C_AL = 3584;
constexpr int NE = 32, FF = 256, LIST_CAP = 32768;
constexpr int NMOD = 8192;
constexpr float EPS = 1e-6f;
constexpr int ACT_ROWS = 73728;

constexpr size_t MiB = 1u << 20;
constexpr size_t WS_CTL = 0, CTL_ZERO_BYTES = 1 * MiB;
constexpr size_t WS_MOD = 1 * MiB;
constexpr size_t WS_TOKW = 2 * MiB;
constexpr size_t WS_LIST = 4 * MiB;
constexpr size_t WS_WIN = 8 * MiB;
constexpr size_t WS_WOUT = 16 * MiB;
constexpr size_t WS_WUP = 18 * MiB;
constexpr size_t WS_WDN = 50 * MiB;
constexpr size_t WS_R2 = 66 * MiB;
constexpr size_t WS_R1 = 130 * MiB;
constexpr size_t WS_ACT = WS_R1;
constexpr size_t WS_Y = WS_R1 + 36 * MiB;
constexpr size_t WS_END = WS_R1 + 240 * MiB;
static_assert(WS_Y + (size_t)M * 2 * D * 2 <= WS_END, "ws map");
static_assert((size_t)ACT_ROWS * FF * 2 <= 36 * MiB, "act map");
constexpr int CW_BAR = 4096;
constexpr int CW_CNT = 1024;

constexpr int LDS_BYTES = 147456;
constexpr int MISC_OFF = 131072 + 320;

__device__ __forceinline__ unsigned f2bf(float f) { unsigned u = __builtin_bit_cast(unsigned, f); return (u + 0x7fffu + ((u >> 16) & 1u)) >> 16; }
__device__ __forceinline__ unsigned pk2(float lo, float hi) { return f2bf(lo) | (f2bf(hi) << 16); }
__device__ __forceinline__ float bf2f(unsigned short b) { return __builtin_bit_cast(float, ((unsigned)b) << 16); }
__device__ __forceinline__ float bflo(unsigned w) { return __builtin_bit_cast(float, w << 16); }
__device__ __forceinline__ float bfhi(unsigned w) { return __builtin_bit_cast(float, w & 0xffff0000u); }
__device__ __forceinline__ float wave_sum(float v) {
#pragma unroll
    for (int o = 1; o < 64; o <<= 1) v += __shfl_xor(v, o);
    return v;
}
__device__ __forceinline__ float sigmoidf_(float x) { return 1.0f / (1.0f + __expf(-x)); }
__device__ __forceinline__ float siluf_(float x) { return x / (1.0f + __expf(-x)); }
#define LDS_WAIT() asm volatile("s_waitcnt lgkmcnt(0)" ::: "memory")

#define XB_TMO      128
#define XB_XCNT(j)  (256  + 64 * (j))
#define XB_XSUB(j)  (1280 + 64 * (j))
#define XB_XGEN(j)  (2304 + 64 * (j))
#define XB_TOP      3328
#define XB_TOPGEN   3392
#define XCD_BAR_WORDS 3456
#define XB_SPIN_CAP (1u << 24)
__device__ __forceinline__ unsigned xb_ld(unsigned* p)              { return __hip_atomic_load(p, __ATOMIC_RELAXED, __HIP_MEMORY_SCOPE_AGENT); }
__device__ __forceinline__ unsigned xb_add(unsigned* p, unsigned v) { return __hip_atomic_fetch_add(p, v, __ATOMIC_RELAXED, __HIP_MEMORY_SCOPE_AGENT); }
__device__ __forceinline__ unsigned xb_xcc_id() { return (unsigned)__builtin_amdgcn_s_getreg((3 << 11) | 20) & 0xFu; }
#define XB_SPIN(cond, bar) do { unsigned _sp = 0; while (cond) { __builtin_amdgcn_s_sleep(1); \
    if ((++_sp & 255u) == 0u) { if (xb_ld(&(bar)[XB_TMO])) break; if (_sp > XB_SPIN_CAP) { atomicAdd(&(bar)[XB_TMO], 1u); break; } } } } while (0)
struct XcdBarrier { unsigned* bar; unsigned x; volatile LAS unsigned* st; };
__device__ __forceinline__ XcdBarrier xcd_barrier_post(unsigned* bar, volatile LAS unsigned* st) {
    XcdBarrier b; b.bar = bar; b.x = xb_xcc_id(); b.st = st;
    if (threadIdx.x == 0) (void)xb_add(&bar[XB_XCNT(b.x)], 1u);
    return b;
}
__device__ __forceinline__ void xcd_barrier_complete(unsigned* bar, unsigned x, unsigned& nloc, unsigned& nx) {
    const unsigned G = gridDim.x * gridDim.y * gridDim.z;
    unsigned sum, cnt, mine, sp = 0u;
    for (;;) {
        sum = 0u; cnt = 0u; mine = 0u;
#pragma unroll
        for (unsigned j = 0; j < 16; ++j) { const unsigned c = xb_ld(&bar[XB_XCNT(j)]); sum += c; cnt += (c > 0u) ? 1u : 0u; mine = (j == x) ? c : mine; }
        if (sum == G) break;
        __builtin_amdgcn_s_sleep(1);
        if ((++sp & 255u) == 0u) { if (xb_ld(&bar[XB_TMO])) break; if (sp > XB_SPIN_CAP) { atomicAdd(&bar[XB_TMO], 1u); break; } }
    }
    nloc = mine > 0u ? mine : 1u; nx = cnt > 0u ? cnt : 1u;
}
__device__ __forceinline__ void xcd_barrier(const XcdBarrier& b) {
    asm volatile("s_waitcnt vmcnt(0)" ::: "memory");
    __syncthreads();
    if (threadIdx.x == 0) {
        unsigned* bar = b.bar;
        __builtin_amdgcn_s_waitcnt(0);
        unsigned nloc = b.st[0], nx = b.st[1];
        if (nloc == 0u) { xcd_barrier_complete(bar, b.x, nloc, nx); b.st[0] = nloc; b.st[1] = nx; }
        const unsigned old = xb_add(&bar[XB_XSUB(b.x)], 1u);
        const unsigned gen = old / nloc;
        if (old + 1u == (gen + 1u) * nloc) {
            __builtin_amdgcn_fence(__ATOMIC_RELEASE, "agent");
            asm volatile("s_waitcnt vmcnt(0)" ::: "memory");
            const unsigned og = xb_add(&bar[XB_TOP], 1u);
            const unsigned tg = og / nx;
            if (og + 1u == (tg + 1u) * nx) xb_add(&bar[XB_TOPGEN], 1u);
            else XB_SPIN(xb_ld(&bar[XB_TOPGEN]) == tg, bar);
            __builtin_amdgcn_fence(__ATOMIC_ACQUIRE, "agent");
            xb_add(&bar[XB_XGEN(b.x)], 1u);
            asm volatile("s_waitcnt vmcnt(0)" ::: "memory");
        } else {
            XB_SPIN(xb_ld(&bar[XB_XGEN(b.x)]) == gen, bar);
            __builtin_amdgcn_fence(__ATOMIC_ACQUIRE, "agent");
            asm volatile("s_waitcnt vmcnt(0)" ::: "memory");
        }
    }
    __syncthreads();
}

struct Args { const float* in[23]; float* out; unsigned char* ws; int ph_lo, ph_hi; };
struct Frame {
    LAS unsigned char* lds;
    int tid, lane, wave, G, bid;
    const float* in[23];
    float* out; unsigned char* ws;
};
enum { I_X = 0, I_C, I_WADA, I_BADA, I_N1G, I_WIN, I_WA2, I_BA, I_GLANG, I_HGNG, I_LB, I_WOUT, I_N2G, I_WRG, I_BRG, I_WRE, I_BRE, I_WEG, I_WEU, I_WED, I_WADAF, I_BADAF, I_NFG };

__device__ __forceinline__ void transpose_item(const float* W, size_t ldw, bf16* WT, size_t ldt, LAS float* scr, int lane) {
#pragma unroll 8
    for (int i = 0; i < 32; ++i) { const int kk = 2 * i + (lane >> 5); scr[kk * 33 + (lane & 31)] = W[(size_t)kk * ldw + (lane & 31)]; }
    LDS_WAIT(); asm volatile("" ::: "memory");
    const int c = lane & 7;
#pragma unroll
    for (int j = 0; j < 4; ++j) { const int n = (lane >> 3) + 8 * j; const LAS float* s = scr + (8 * c) * 33 + n;
        v4u o; o.x = pk2(s[0 * 33], s[1 * 33]); o.y = pk2(s[2 * 33], s[3 * 33]); o.z = pk2(s[4 * 33], s[5 * 33]); o.w = pk2(s[6 * 33], s[7 * 33]);
        *(v4u*)(WT + (size_t)n * ldt + 8 * c) = o; }
    LDS_WAIT(); asm volatile("" ::: "memory");
}

__device__ __forceinline__ void phase_prologue(Frame& F) {
    const float* w_in = F.in[I_WIN]; const float* w_out = F.in[I_WOUT];
    bf16* Win_t = (bf16*)(F.ws + WS_WIN); bf16* Wout_t = (bf16*)(F.ws + WS_WOUT); bf16* Wup_t = (bf16*)(F.ws + WS_WUP); bf16* Wdn_t = (bf16*)(F.ws + WS_WDN);
    LAS float* scr = (LAS float*)(F.lds + F.wave * 16384);
    const int gw = F.bid * 8 + F.wave, NGW = F.G * 8;
    constexpr int I_A = 16 * 112, I_B = 16 * 32, I_E = 32 * 128;
    constexpr int NITEMS = I_A + I_B + 3 * I_E;
    for (int it = gw; it < NITEMS; it += NGW) {
        int r = it;
        if (r < I_A) { const int kb = r / 112, nb = r % 112, n0 = 32 * nb, src = n0 < 1536 ? n0 : n0 + 16;
            transpose_item(w_in + (size_t)(64 * kb) * IN_COLS + src, IN_COLS, Win_t + (size_t)n0 * D + 64 * kb, D, scr, F.lane); continue; }
        r -= I_A;
        if (r < I_B) { const int kb = r / 32, nb = r % 32;
            transpose_item(w_out + (size_t)(64 * kb) * D + 32 * nb, D, Wout_t + (size_t)(32 * nb) * D + 64 * kb, D, scr, F.lane); continue; }
        r -= I_B;
        if (r < 2 * I_E) { const int up = r >= I_E; if (up) r -= I_E; const int e = r / 128, q = r % 128, kb = q / 8, nb = q % 8, f0 = 32 * nb;
            const int drow = (f0 / 128) * 256 + (f0 % 128) + (up ? 128 : 0);
            const float* W = (up ? F.in[I_WEU] : F.in[I_WEG]) + (size_t)e * D * FF + (size_t)(64 * kb) * FF + f0;
            transpose_item(W, FF, Wup_t + ((size_t)e * 512 + drow) * D + 64 * kb, D, scr, F.lane); continue; }
        r -= 2 * I_E;
        { const int e = r / 128, q = r % 128, kb = q / 32, nb = q % 32;
            transpose_item(F.in[I_WED] + (size_t)e * FF * D + (size_t)(64 * kb) * D + 32 * nb, D, Wdn_t + ((size_t)e * D + 32 * nb) * FF + 64 * kb, FF, scr, F.lane); }
    }
    {
        const float* wa2 = F.in[I_WA2];
        for (int idx = F.bid * 512 + F.tid; idx < 256 * D; idx += F.G * 512) {
            const int j = idx / D, k = idx % D; float s = 0.f;
#pragma unroll
            for (int r = 0; r < 16; ++r) s += w_in[(size_t)k * IN_COLS + 1536 + r] * wa2[r * 256 + j];
            Win_t[(size_t)(C_AL + j) * D + k] = (bf16)f2bf(s);
        }
    }
    __syncthreads();
    {
        LAS float* cact = (LAS float*)F.lds;
        LAS float* red = (LAS float*)(F.lds + 65536);
        const float* c = F.in[I_C];
        for (int i = F.tid; i < NB * D; i += 512) { const int b = i / D, k = i % D; cact[k * 16 + b] = siluf_(c[i]); }
        __syncthreads();
        float* mod = (float*)(F.ws + WS_MOD);
        for (int cb = F.bid; cb < NMOD / 32; cb += F.G) {
            const int n = cb * 32 + (F.lane & 31);
            const float* W; size_t ldw;
            if (n < 6144) { W = F.in[I_WADA] + n; ldw = 6144; } else { W = F.in[I_WADAF] + (n - 6144); ldw = 2048; }
            float acc[16];
#pragma unroll
            for (int b = 0; b < 16; ++b) acc[b] = 0.f;
            for (int i = 0; i < 64; ++i) {
                const int k = 128 * F.wave + 2 * i + (F.lane >> 5);
                const float w = W[(size_t)k * ldw];
                const LAS f32x4* cp = (const LAS f32x4*)(cact + k * 16);
#pragma unroll
                for (int q = 0; q < 4; ++q) { const f32x4 cv = cp[q]; acc[4 * q + 0] += cv.x * w; acc[4 * q + 1] += cv.y * w; acc[4 * q + 2] += cv.z * w; acc[4 * q + 3] += cv.w * w; }
            }
#pragma unroll
            for (int b = 0; b < 16; ++b) acc[b] += __shfl_xor(acc[b], 32);
            if (F.lane < 32) {
#pragma unroll
                for (int b = 0; b < 16; ++b) red[(F.wave * 16 + b) * 32 + F.lane] = acc[b];
            }
            __syncthreads();
            { const int b = F.tid >> 5, cc = F.tid & 31; float s = 0.f;
#pragma unroll
                for (int w = 0; w < 8; ++w) s += red[(w * 16 + b) * 32 + cc];
                const int nn = cb * 32 + cc; const float bb = nn < 6144 ? F.in[I_BADA][nn] : F.in[I_BADAF][nn - 6144];
                mod[(size_t)b * NMOD + nn] = s + bb; }
            __syncthreads();
        }
    }
}

__device__ __forceinline__ void load_row16(const float* p, int lane, f32x4 (&v)[4]) {
    const f32x4* r = (const f32x4*)p + lane;
#pragma unroll
    for (int j = 0; j < 4; ++j) v[j] = r[64 * j];
}
__device__ __forceinline__ float sumsq16(const f32x4 (&v)[4]) {
    float s = 0.f;
#pragma unroll
    for (int j = 0; j < 4; ++j) s += (v[j].x * v[j].x + v[j].y * v[j].y) + (v[j].z * v[j].z + v[j].w * v[j].w);
    return s;
}
__device__ __forceinline__ void store_row16_bf16(bf16* p, int lane, const f32x4 (&v)[4]) {
    v2u* o = (v2u*)p + lane;
#pragma unroll
    for (int j = 0; j < 4; ++j) { v2u w; w.x = pk2(v[j].x, v[j].y); w.y = pk2(v[j].z, v[j].w); o[64 * j] = w; }
}
__device__ __forceinline__ void norm_mod16(f32x4 (&v)[4], float r, const float* g, const float* sc, const float* sh, int lane) {
    f32x4 gv[4], scv[4], shv[4]; load_row16(g, lane, gv); load_row16(sc, lane, scv); load_row16(sh, lane, shv);
#pragma unroll
    for (int j = 0; j < 4; ++j) v[j] = v[j] * r * gv[j] * (1.0f + scv[j]) + shv[j];
}

__device__ __forceinline__ void phase_norm1(Frame& F) {
    const float* x = F.in[I_X]; const float* mod = (const float*)(F.ws + WS_MOD); bf16* h = (bf16*)(F.ws + WS_R2);
    const int gw = F.bid * 8 + F.wave, NGW = F.G * 8;
    for (int m = gw; m < M; m += NGW) {
        const int b = m / SEQ; f32x4 v[4]; load_row16(x + (size_t)m * D, F.lane, v);
        const float r = 1.0f / sqrtf(wave_sum(sumsq16(v)) * (1.0f / D) + EPS);
        norm_mod16(v, r, F.in[I_N1G], mod + (size_t)b * NMOD + 1024, mod + (size_t)b * NMOD, F.lane);
        store_row16_bf16(h + (size_t)m * D, F.lane, v);
    }
}

__device__ __forceinline__ void naive_tile(LAS unsigned char* lds, const bf16* A, size_t lda, const LAS int* rowidx, const bf16* Bt, size_t ldb, int K, int tid, float (&acc)[4][8]) {
    LAS float* As = (LAS float*)lds;
    LAS float* Bs = (LAS float*)(lds + 32 * 132 * 4);
    const int ty = tid >> 4, tx = tid & 15;
    const int lr = tid >> 2, kp = (tid & 3) * 8;
    const size_t arow = rowidx ? (size_t)rowidx[lr] : (size_t)lr;
    for (int k0 = 0; k0 < K; k0 += 32) {
        const v4u av = *(const v4u*)(A + arow * lda + k0 + kp);
        const v4u bv = *(const v4u*)(Bt + (size_t)lr * ldb + k0 + kp);
        __syncthreads();
        As[(kp + 0) * 132 + lr] = bflo(av.x); As[(kp + 1) * 132 + lr] = bfhi(av.x); As[(kp + 2) * 132 + lr] = bflo(av.y); As[(kp + 3) * 132 + lr] = bfhi(av.y);
        As[(kp + 4) * 132 + lr] = bflo(av.z); As[(kp + 5) * 132 + lr] = bfhi(av.z); As[(kp + 6) * 132 + lr] = bflo(av.w); As[(kp + 7) * 132 + lr] = bfhi(av.w);
        Bs[(kp + 0) * 132 + lr] = bflo(bv.x); Bs[(kp + 1) * 132 + lr] = bfhi(bv.x); Bs[(kp + 2) * 132 + lr] = bflo(bv.y); Bs[(kp + 3) * 132 + lr] = bfhi(bv.y);
        Bs[(kp + 4) * 132 + lr] = bflo(bv.z); Bs[(kp + 5) * 132 + lr] = bfhi(bv.z); Bs[(kp + 6) * 132 + lr] = bflo(bv.w); Bs[(kp + 7) * 132 + lr] = bfhi(bv.w);
        __syncthreads();
#pragma unroll 4
        for (int kk = 0; kk < 32; ++kk) {
            const f32x4 a = *(const LAS f32x4*)(As + kk * 132 + ty * 4);
            const f32x4 b0 = *(const LAS f32x4*)(Bs + kk * 132 + tx * 8), b1 = *(const LAS f32x4*)(Bs + kk * 132 + tx * 8 + 4);
            const float av4[4] = {a.x, a.y, a.z, a.w}; const float bv8[8] = {b0.x, b0.y, b0.z, b0.w, b1.x, b1.y, b1.z, b1.w};
#pragma unroll
            for (int i = 0; i < 4; ++i)
#pragma unroll
                for (int j = 0; j < 8; ++j) acc[i][j] += av4[i] * bv8[j];
        }
    }
    __syncthreads();
}
#define ZERO_ACC(acc) do { _Pragma("unroll") for (int _i = 0; _i < 4; ++_i) _Pragma("unroll") for (int _j = 0; _j < 8; ++_j) acc[_i][_j] = 0.f; } while (0)

__device__ __forceinline__ void phase_gemm1_naive(Frame& F) {
    const bf16* h = (const bf16*)(F.ws + WS_R2); const bf16* Wt = (const bf16*)(F.ws + WS_WIN); bf16* proj = (bf16*)(F.ws + WS_R1);
    const int ty = F.tid >> 4, tx = F.tid & 15;
    constexpr int NTN = NP / 128, NT = (M / 128) * NTN;
    for (int t = F.bid; t < NT; t += F.G) {
        const int tm = t / NTN, tn = t % NTN; float acc[4][8]; ZERO_ACC(acc);
        naive_tile(F.lds, h + (size_t)tm * 128 * D, D, nullptr, Wt + (size_t)tn * 128 * D, D, D, F.tid, acc);
#pragma unroll
        for (int i = 0; i < 4; ++i) { v4u o; o.x = pk2(acc[i][0], acc[i][1]); o.y = pk2(acc[i][2], acc[i][3]); o.z = pk2(acc[i][4], acc[i][5]); o.w = pk2(acc[i][6], acc[i][7]);
            *(v4u*)(proj + (size_t)(tm * 128 + ty * 4 + i) * NP + tn * 128 + tx * 8) = o; }
    }
}

__device__ __forceinline__ void phase_scan_naive(Frame& F) {
    const bf16* proj = (const bf16*)(F.ws + WS_R1); bf16* o = (bf16*)(F.ws + WS_R2);
    LAS float* gA = (LAS float*)F.lds;
    LAS float* gK = gA + 16 * 128;
    LAS float* gQ = gK + 16 * 128;
    LAS float* part = gQ + 16 * 128;
    const int c = F.tid & 127, kq = F.tid >> 7;
    for (int u = F.bid; u < NB * 8; u += F.G) {
        const int b = u >> 3, hh = u & 7; const bool gla = hh < 4; const int hd = hh & 3;
        const int dk = gla ? 64 : 128, kper = dk / 4;
        float Sreg[32];
#pragma unroll
        for (int i = 0; i < 32; ++i) Sreg[i] = 0.f;
        const int vcol = gla ? C_GV + hd * 128 : C_HI + hd * 128;
        const int gcol = gla ? C_GG + hd * 128 : C_HG + hd * 128;
        const float* ng = gla ? F.in[I_GLANG] : F.in[I_HGNG];
        for (int t0 = 0; t0 < SEQ; t0 += 16) {
            __syncthreads();
            for (int i = F.tid; i < 16 * dk; i += 512) {
                const int r = i / dk, k = i % dk; const size_t m = (size_t)b * SEQ + t0 + r; const bf16* pr = proj + m * NP;
                float a, kk, qq;
                if (gla) { const float al = bf2f(pr[C_AL + hd * 64 + k]) + F.in[I_BA][hd * 64 + k];
                    const float ls = fminf(al, 0.f) - log1pf(__expf(-fabsf(al)));
                    a = __expf(ls * (1.0f / 16.0f)); kk = bf2f(pr[C_GK + hd * 64 + k]); qq = bf2f(pr[C_GQ + hd * 64 + k]) * 0.125f; }
                else { const int j = hd * 128 + k; const float l0 = F.in[I_LB][j], l1 = F.in[I_LB][512 + j]; const float lb = 1.0f / (1.0f + __expf(l1 - l0));
                    const float f = lb + (1.0f - lb) * sigmoidf_(bf2f(pr[C_HF + j]));
                    a = f; kk = 1.0f - f; qq = bf2f(pr[C_HQ + j]) * 0.08838834764831845f; }
                gA[r * 128 + k] = a; gK[r * 128 + k] = kk; gQ[r * 128 + k] = qq;
            }
            __syncthreads();
            for (int r = 0; r < 16; ++r) {
                const size_t m = (size_t)b * SEQ + t0 + r; const float v = bf2f(proj[m * NP + vcol + c]); float po = 0.f;
#pragma unroll
                for (int i = 0; i < 32; ++i) { if (i < kper) { const int k = kq * kper + i; Sreg[i] = gA[r * 128 + k] * Sreg[i] + gK[r * 128 + k] * v; po += gQ[r * 128 + k] * Sreg[i]; } }
                part[(r * 4 + kq) * 128 + c] = po;
            }
            __syncthreads();
            { const int r = F.tid >> 5, c4 = (F.tid & 31) * 4; const size_t m = (size_t)b * SEQ + t0 + r;
                float ov[4]; float ss = 0.f;
#pragma unroll
                for (int e = 0; e < 4; ++e) { ov[e] = part[(r * 4 + 0) * 128 + c4 + e] + part[(r * 4 + 1) * 128 + c4 + e] + part[(r * 4 + 2) * 128 + c4 + e] + part[(r * 4 + 3) * 128 + c4 + e]; ss += ov[e] * ov[e]; }
#pragma unroll
                for (int off = 1; off < 32; off <<= 1) ss += __shfl_xor(ss, off);
                const float rr = 1.0f / sqrtf(ss * (1.0f / 128.0f) + EPS);
                const v2u gw = *(const v2u*)(proj + m * NP + gcol + c4);
                const float g4[4] = {bflo(gw.x), bfhi(gw.x), bflo(gw.y), bfhi(gw.y)}; float res[4];
#pragma unroll
                for (int e = 0; e < 4; ++e) res[e] = ov[e] * rr * ng[c4 + e] * siluf_(g4[e]);
                v2u w; w.x = pk2(res[0], res[1]); w.y = pk2(res[2], res[3]);
                *(v2u*)(o + m * D + hh * 128 + c4) = w; }
        }
    }
}

__device__ __forceinline__ void phase_gemm_out_naive(Frame& F) {
    const bf16* o = (const bf16*)(F.ws + WS_R2); const bf16* Wt = (const bf16*)(F.ws + WS_WOUT); const float* mod = (const float*)(F.ws + WS_MOD);
    const float* x = F.in[I_X];
    const int ty = F.tid >> 4, tx = F.tid & 15;
    constexpr int NTN = D / 128, NT = (M / 128) * NTN;
    for (int t = F.bid; t < NT; t += F.G) {
        const int tm = t / NTN, tn = t % NTN; float acc[4][8]; ZERO_ACC(acc);
        naive_tile(F.lds, o + (size_t)tm * 128 * D, D, nullptr, Wt + (size_t)tn * 128 * D, D, D, F.tid, acc);
#pragma unroll
        for (int i = 0; i < 4; ++i) { const int m = tm * 128 + ty * 4 + i, n0 = tn * 128 + tx * 8, b = m / SEQ;
            const float* gt = mod + (size_t)b * NMOD + 2048 + n0; const float* xr = x + (size_t)m * D + n0; float* orow = F.out + (size_t)m * D + n0;
#pragma unroll
            for (int j = 0; j < 8; ++j) orow[j] = xr[j] + gt[j] * acc[i][j]; }
    }
}

__device__ __forceinline__ void phase_norm2_route(Frame& F) {
    const float* x1 = F.out; const float* mod = (const float*)(F.ws + WS_MOD); bf16* h2 = (bf16*)(F.ws + WS_R2);
    float* tokw = (float*)(F.ws + WS_TOKW); int* list = (int*)(F.ws + WS_LIST); unsigned* gcnt = (unsigned*)(F.ws + WS_CTL) + CW_CNT;
    LAS int* lcnt = (LAS int*)F.lds;
    LAS int* lbase = lcnt + 32;
    LAS int* ebuf = lbase + 32;
    constexpr int CAP = 4096;
    if (F.tid < 32) lcnt[F.tid] = 0;
    __syncthreads();
    const float* wrg = F.in[I_WRG]; const float* wre = F.in[I_WRE];
    int it = 0;
    for (int m = F.bid * 8 + F.wave; m < M; m += F.G * 8, ++it) {
        const int b = m / SEQ; f32x4 v[4]; load_row16(x1 + (size_t)m * D, F.lane, v);
        const float r = 1.0f / sqrtf(wave_sum(sumsq16(v)) * (1.0f / D) + EPS);
        norm_mod16(v, r, F.in[I_N2G], mod + (size_t)b * NMOD + 4096, mod + (size_t)b * NMOD + 3072, F.lane);
        store_row16_bf16(h2 + (size_t)m * D, F.lane, v);
        float lg[36];
#pragma unroll
        for (int j = 0; j < 36; ++j) lg[j] = 0.f;
#pragma unroll
        for (int j = 0; j < 4; ++j) {
            const float hv[4] = {v[j].x, v[j].y, v[j].z, v[j].w};
#pragma unroll
            for (int i = 0; i < 4; ++i) { const int k = 4 * F.lane + 256 * j + i;
                const f32x4 g4 = *(const f32x4*)(wrg + (size_t)k * 4);
                lg[0] += hv[i] * g4.x; lg[1] += hv[i] * g4.y; lg[2] += hv[i] * g4.z; lg[3] += hv[i] * g4.w;
#pragma unroll
                for (int q = 0; q < 8; ++q) { const f32x4 e4 = *(const f32x4*)(wre + (size_t)k * 32 + 4 * q);
                    lg[4 + 4 * q + 0] += hv[i] * e4.x; lg[4 + 4 * q + 1] += hv[i] * e4.y; lg[4 + 4 * q + 2] += hv[i] * e4.z; lg[4 + 4 * q + 3] += hv[i] * e4.w; } }
        }
#pragma unroll
        for (int j = 0; j < 36; ++j) lg[j] = wave_sum(lg[j]);
#pragma unroll
        for (int j = 0; j < 4; ++j) lg[j] += F.in[I_BRG][j];
#pragma unroll
        for (int j = 0; j < 32; ++j) lg[4 + j] += F.in[I_BRE][j];
        int g = 0; float gm = lg[0];
#pragma unroll
        for (int j = 1; j < 4; ++j) if (lg[j] > gm) { gm = lg[j]; g = j; }
        float gs = 0.f;
#pragma unroll
        for (int j = 0; j < 4; ++j) gs += __expf(lg[j] - gm);
        const float gp = 1.0f / gs;
        float sel[8];
#pragma unroll
        for (int i = 0; i < 8; ++i) { sel[i] = lg[4 + i];
#pragma unroll
            for (int gg = 1; gg < 4; ++gg) sel[i] = (g == gg) ? lg[4 + gg * 8 + i] : sel[i]; }
        int i0 = 0; float s0 = sel[0];
#pragma unroll
        for (int i = 1; i < 8; ++i) if (sel[i] > s0) { s0 = sel[i]; i0 = i; }
        int i1 = -1; float s1 = -3.0e38f;
#pragma unroll
        for (int i = 0; i < 8; ++i) if (i != i0 && sel[i] > s1) { s1 = sel[i]; i1 = i; }
        const float e1 = __expf(s1 - s0); const float p0 = 1.0f / (1.0f + e1), p1 = e1 / (1.0f + e1);
        if (F.lane == 0) {
            const int ex0 = g * 8 + i0, ex1 = g * 8 + i1;
            tokw[(size_t)m * 2 + 0] = gp * p0; tokw[(size_t)m * 2 + 1] = gp * p1;
            const int r0 = atomicAdd((int*)(lcnt + ex0), 1); const int r1 = atomicAdd((int*)(lcnt + ex1), 1);
            const int n = (it * 8 + F.wave) * 2;
            if (n + 1 < CAP) { ebuf[2 * n] = m * 2; ebuf[2 * n + 1] = (ex0 << 20) | r0; ebuf[2 * n + 2] = m * 2 + 1; ebuf[2 * n + 3] = (ex1 << 20) | r1; }
        }
    }
    __syncthreads();
    if (F.tid < 32) lbase[F.tid] = (int)atomicAdd(gcnt + F.tid, (unsigned)lcnt[F.tid]);
    __syncthreads();
    const int nrows = (M - F.bid * 8 + F.G * 8 - 1) / (F.G * 8);
    const int nent = nrows * 16 < CAP ? nrows * 16 : CAP;
    for (int n = F.tid; n < nent; n += 512) {
        const int itn = n >> 4, wv = (n >> 1) & 7; const int m = F.bid * 8 + wv + itn * F.G * 8;
        if (m < M) { const int tok2 = ebuf[2 * n], er = ebuf[2 * n + 1]; const int e = er >> 20, rk = er & 0xfffff;
            list[(size_t)e * LIST_CAP + lbase[e] + rk] = tok2; }
    }
}

struct MoeMap { int cnt[NE]; int rowbase[NE]; };
__device__ __forceinline__ void moe_map_build(Frame& F, LAS int* mcnt, LAS int* mbase) {
    const unsigned* gcnt = (const unsigned*)(F.ws + WS_CTL) + CW_CNT;
    __syncthreads();
    if (F.tid == 0) { int acc = 0; for (int e = 0; e < NE; ++e) { const int c = (int)gcnt[e]; mcnt[e] = c; mbase[e] = acc; acc += ((c + 255) / 256) * 256; } }
    __syncthreads();
}

__device__ __forceinline__ void phase_moe_up_naive(Frame& F) {
    const bf16* h2 = (const bf16*)(F.ws + WS_R2); const bf16* Wup = (const bf16*)(F.ws + WS_WUP); bf16* act = (bf16*)(F.ws + WS_ACT);
    const int* list = (const int*)(F.ws + WS_LIST);
    LAS int* mcnt = (LAS int*)(F.lds + 40960); LAS int* mbase = mcnt + 32; LAS int* ridx = mbase + 32;
    moe_map_build(F, mcnt, mbase);
    const int ty = F.tid >> 4, tx = F.tid & 15;
    int total = 0;
    for (int e = 0; e < NE; ++e) total += ((mcnt[e] + 127) / 128) * 2;
    for (int u = F.bid; u < total; u += F.G) {
        int e = 0, rem = u;
        for (; e < NE; ++e) { const int n = ((mcnt[e] + 127) / 128) * 2; if (rem < n) break; rem -= n; }
        const int rt = rem >> 1, fb = rem & 1;
        __syncthreads();
        if (F.tid < 128) { const int r = rt * 128 + F.tid; ridx[F.tid] = r < mcnt[e] ? (list[(size_t)e * LIST_CAP + r] >> 1) : 0; }
        __syncthreads();
        float ag[4][8], au[4][8]; ZERO_ACC(ag); ZERO_ACC(au);
        const bf16* Wg = Wup + ((size_t)e * 512 + fb * 256) * D;
        naive_tile(F.lds, h2, D, ridx, Wg, D, D, F.tid, ag);
        naive_tile(F.lds, h2, D, ridx, Wg + (size_t)128 * D, D, D, F.tid, au);
#pragma unroll
        for (int i = 0; i < 4; ++i) { float r8[8];
#pragma unroll
            for (int j = 0; j < 8; ++j) r8[j] = siluf_(ag[i][j]) * au[i][j];
            v4u o; o.x = pk2(r8[0], r8[1]); o.y = pk2(r8[2], r8[3]); o.z = pk2(r8[4], r8[5]); o.w = pk2(r8[6], r8[7]);
            *(v4u*)(act + (size_t)(mbase[e] + rt * 128 + ty * 4 + i) * FF + fb * 128 + tx * 8) = o; }
    }
}
__device__ __forceinline__ void phase_moe_down_naive(Frame& F) {
    const bf16* act = (const bf16*)(F.ws + WS_ACT); const bf16* Wdn = (const bf16*)(F.ws + WS_WDN); bf16* y = (bf16*)(F.ws + WS_Y);
    const int* list = (const int*)(F.ws + WS_LIST);
    LAS int* mcnt = (LAS int*)(F.lds + 40960); LAS int* mbase = mcnt + 32;
    moe_map_build(F, mcnt, mbase);
    const int ty = F.tid >> 4, tx = F.tid & 15;
    int total = 0;
    for (int e = 0; e < NE; ++e) total += ((mcnt[e] + 127) / 128) * 8;
    for (int u = F.bid; u < total; u += F.G) {
        int e = 0, rem = u;
        for (; e < NE; ++e) { const int n = ((mcnt[e] + 127) / 128) * 8; if (rem < n) break; rem -= n; }
        const int rt = rem >> 3, ct = rem & 7;
        float acc[4][8]; ZERO_ACC(acc);
        naive_tile(F.lds, act + (size_t)(mbase[e] + rt * 128) * FF, FF, nullptr, Wdn + ((size_t)e * D + ct * 128) * FF, FF, FF, F.tid, acc);
#pragma unroll
        for (int i = 0; i < 4; ++i) { const int r = rt * 128 + ty * 4 + i;
            if (r < mcnt[e]) { const int ent = list[(size_t)e * LIST_CAP + r];
                v4u o; o.x = pk2(acc[i][0], acc[i][1]); o.y = pk2(acc[i][2], acc[i][3]); o.z = pk2(acc[i][4], acc[i][5]); o.w = pk2(acc[i][6], acc[i][7]);
                *(v4u*)(y + (size_t)ent * D + ct * 128 + tx * 8) = o; } }
    }
}

__device__ __forceinline__ void phase_final(Frame& F) {
    const float* mod = (const float*)(F.ws + WS_MOD); const bf16* y = (const bf16*)(F.ws + WS_Y); const float* tokw = (const float*)(F.ws + WS_TOKW);
    const int gw = F.bid * 8 + F.wave, NGW = F.G * 8;
    for (int m = gw; m < M; m += NGW) {
        const int b = m / SEQ; f32x4 v[4]; load_row16(F.out + (size_t)m * D, F.lane, v);
        const float w0 = tokw[(size_t)m * 2], w1 = tokw[(size_t)m * 2 + 1];
        f32x4 gt[4]; load_row16(mod + (size_t)b * NMOD + 5120, F.lane, gt);
        const v2u* y0 = (const v2u*)(y + (size_t)(2 * m) * D) + F.lane; const v2u* y1 = (const v2u*)(y + (size_t)(2 * m + 1) * D) + F.lane;
#pragma unroll
        for (int j = 0; j < 4; ++j) { const v2u a = y0[64 * j], c = y1[64 * j];
            f32x4 f; f.x = w0 * bflo(a.x) + w1 * bflo(c.x); f.y = w0 * bfhi(a.x) + w1 * bfhi(c.x); f.z = w0 * bflo(a.y) + w1 * bflo(c.y); f.w = w0 * bfhi(a.y) + w1 * bfhi(c.y);
            v[j] = v[j] + gt[j] * f; }
        const float r = 1.0f / sqrtf(wave_sum(sumsq16(v)) * (1.0f / D) + EPS);
        norm_mod16(v, r, F.in[I_NFG], mod + (size_t)b * NMOD + 6144 + 1024, mod + (size_t)b * NMOD + 6144, F.lane);
        f32x4* orow = (f32x4*)(F.out + (size_t)m * D) + F.lane;
#pragma unroll
        for (int j = 0; j < 4; ++j) orow[64 * j] = v[j];
    }
}

constexpr int N_PHASES = 10;
__global__ void __launch_bounds__(512, 2) fwd(Args args) {
    extern __shared__ __attribute__((aligned(16))) unsigned char lds_raw[];
    Frame F;
    F.lds = (LAS unsigned char*)lds_raw;
    F.tid = threadIdx.x; F.lane = F.tid & 63; F.wave = __builtin_amdgcn_readfirstlane(F.tid >> 6);
    F.G = gridDim.x; F.bid = blockIdx.x;
#pragma unroll
    for (int i = 0; i < 23; ++i) F.in[i] = args.in[i];
    F.out = args.out; F.ws = args.ws;
    volatile LAS unsigned* MISC = (volatile LAS unsigned*)(F.lds + MISC_OFF);
    if (F.tid < 32) MISC[F.tid] = 0u;
    __syncthreads();
    unsigned* barw = (unsigned*)(F.ws + WS_CTL) + CW_BAR;
    const bool multi = (args.ph_hi - args.ph_lo) > 1;
    XcdBarrier bar; bar.bar = barw; bar.x = 0; bar.st = MISC + 8;
    if (multi) bar = xcd_barrier_post(barw, MISC + 8);
    const int lo = args.ph_lo, hi = args.ph_hi;
#define IN(k) (lo <= (k) && (k) < hi)
#define SEAM(k) do { if (IN(k) && IN((k) + 1)) xcd_barrier(bar); } while (0)
    if (IN(0)) { phase_prologue(F); } SEAM(0);
    if (IN(1)) { phase_norm1(F); } SEAM(1);
    if (IN(2)) { phase_gemm1_naive(F); } SEAM(2);
    if (IN(3)) { phase_scan_naive(F); } SEAM(3);
    if (IN(4)) { phase_gemm_out_naive(F); } SEAM(4);
    if (IN(5)) { phase_norm2_route(F); } SEAM(5);
    if (IN(6)) { phase_moe_up_naive(F); } SEAM(6);
    if (IN(7)) { phase_moe_down_naive(F); } SEAM(7);
    if (IN(8)) { phase_final(F); }
#undef IN
#undef SEAM
}

#ifndef MK_N_LAUNCHES
#define MK_N_LAUNCHES 1
#endif
extern "C" void kernel_launch(void* const* d_in, const int* in_sizes, int n_in, void* d_out, int out_size, void* d_ws, size_t ws_size, hipStream_t stream) {
    static int grid = 0;
    if (grid == 0) {
        if (n_in != 23 || out_size != M * D || ws_size < WS_END) { fprintf(stderr, "kernel_launch: unexpected shapes (n_in %d out %d ws %zu)\n", n_in, out_size, ws_size); grid = -1; return; }
        int dev = 0, cus = 0, per_cu = 0;
        if (hipGetDevice(&dev) != hipSuccess || hipDeviceGetAttribute(&cus, hipDeviceAttributeMultiprocessorCount, dev) != hipSuccess) { grid = -1; return; }
        if (hipFuncSetAttribute((const void*)fwd, hipFuncAttributeMaxDynamicSharedMemorySize, LDS_BYTES) != hipSuccess) { fprintf(stderr, "kernel_launch: hipFuncSetAttribute failed\n"); grid = -1; return; }
        if (hipOccupancyMaxActiveBlocksPerMultiprocessor(&per_cu, (const void*)fwd, 512, LDS_BYTES) != hipSuccess || per_cu < 1) fprintf(stderr, "kernel_launch: occupancy query says %d\n", per_cu);
        (void)hipGetLastError();
        grid = cus;
    }
    if (grid < 0) return;
    (void)hipMemsetAsync((char*)d_ws + WS_CTL, 0, CTL_ZERO_BYTES, stream);
    Args a{};
    for (int i = 0; i < 23; ++i) a.in[i] = (const float*)d_in[i];
    a.out = (float*)d_out; a.ws = (unsigned char*)d_ws;
    if (MK_N_LAUNCHES == 1) { a.ph_lo = 0; a.ph_hi = N_PHASES; hipLaunchKernelGGL(fwd, dim3(grid), dim3(512), LDS_BYTES, stream, a); }
    else { for (int p = 0; p < 9; ++p) { a.ph_lo = p; a.ph_hi = p + 1; hipLaunchKernelGGL(fwd, dim3(grid), dim3(512), LDS_BYTES, stream, a); } }
}
```

```cpp
#include <hip/hip_runtime.h>
#include <cstdio>
#include <cstdint>

#define GAS __attribute__((address_space(1)))
#define LAS __attribute__((address_space(3)))
typedef unsigned short bf16;
typedef unsigned v4u __attribute__((ext_vector_type(4)));
typedef unsigned v2u __attribute__((ext_vector_type(2)));
typedef float f32x4 __attribute__((ext_vector_type(4)));

#ifndef FAST_GEMM1
#define FAST_GEMM1 1
#endif
#ifndef FAST_GEMMO
#define FAST_GEMMO 1
#endif
#ifndef FAST_MOE
#define FAST_MOE 1
#endif
#ifndef FAST_SCAN
#define FAST_SCAN 1
#endif
constexpr int NB = 16, SEQ = 2048, D = 1024, M = NB * SEQ;
constexpr int IN_COLS = 3600;
constexpr int NP = 3840;
constexpr int C_GQ = 0, C_GK = 256, C_GV = 512, C_GG = 1024, C_HQ = 1536, C_HF = 2048, C_HI = 2560, C_HG = 3072, C_AL = 3584;
constexpr int NE = 32, FF = 256, LIST_CAP = 32768;
constexpr int NMOD = 8192;
constexpr float EPS = 1e-6f;
constexpr int ACT_ROWS = 73728;

constexpr size_t MiB = 1u << 20;
constexpr size_t WS_CTL = 0, CTL_ZERO_BYTES = 1 * MiB;
constexpr size_t WS_MOD = 1 * MiB;
constexpr size_t WS_TOKW = 2 * MiB;
constexpr size_t WS_LIST = 4 * MiB;
constexpr size_t WS_WIN = 8 * MiB;
constexpr size_t WS_WOUT = 16 * MiB;
constexpr size_t WS_WUP = 18 * MiB;
constexpr size_t WS_WDN = 50 * MiB;
constexpr size_t WS_R2 = 66 * MiB;
constexpr size_t WS_R1 = 130 * MiB;
constexpr size_t WS_ACT = WS_R1;
constexpr size_t WS_Y = WS_R1 + 36 * MiB;
constexpr size_t WS_END = WS_R1 + 240 * MiB;
static_assert(WS_Y + (size_t)M * 2 * D * 2 <= WS_END, "ws map");
static_assert((size_t)ACT_ROWS * FF * 2 <= 36 * MiB, "act map");
constexpr int CW_BAR = 4096;
constexpr int CW_CNT = 1024;

constexpr int LDS_BYTES = 163840;
constexpr int MISC_OFF = 163840 - 128;

__device__ __forceinline__ unsigned f2bf(float f) { unsigned u = __builtin_bit_cast(unsigned, f); return (u + 0x7fffu + ((u >> 16) & 1u)) >> 16; }
__device__ __forceinline__ unsigned pk2(float lo, float hi) { return f2bf(lo) | (f2bf(hi) << 16); }
__device__ __forceinline__ float bf2f(unsigned short b) { return __builtin_bit_cast(float, ((unsigned)b) << 16); }
__device__ __forceinline__ float bflo(unsigned w) { return __builtin_bit_cast(float, w << 16); }
__device__ __forceinline__ float bfhi(unsigned w) { return __builtin_bit_cast(float, w & 0xffff0000u); }
__device__ __forceinline__ float wave_sum(float v) {
#pragma unroll
    for (int o = 1; o < 64; o <<= 1) v += __shfl_xor(v, o);
    return v;
}
__device__ __forceinline__ float sigmoidf_(float x) { return 1.0f / (1.0f + __expf(-x)); }
__device__ __forceinline__ float siluf_(float x) { return x / (1.0f + __expf(-x)); }
#define LDS_WAIT() asm volatile("s_waitcnt lgkmcnt(0)" ::: "memory")

#define XB_TMO      128
#define XB_XCNT(j)  (256  + 64 * (j))
#define XB_XSUB(j)  (1280 + 64 * (j))
#define XB_XGEN(j)  (2304 + 64 * (j))
#define XB_TOP      3328
#define XB_TOPGEN   3392
#define XCD_BAR_WORDS 3456
#define XB_SPIN_CAP (1u << 24)
__device__ __forceinline__ unsigned xb_ld(unsigned* p)              { return __hip_atomic_load(p, __ATOMIC_RELAXED, __HIP_MEMORY_SCOPE_AGENT); }
__device__ __forceinline__ unsigned xb_add(unsigned* p, unsigned v) { return __hip_atomic_fetch_add(p, v, __ATOMIC_RELAXED, __HIP_MEMORY_SCOPE_AGENT); }
__device__ __forceinline__ unsigned xb_xcc_id() { return (unsigned)__builtin_amdgcn_s_getreg((3 << 11) | 20) & 0xFu; }
#define XB_SPIN(cond, bar) do { unsigned _sp = 0; while (cond) { __builtin_amdgcn_s_sleep(1); \
    if ((++_sp & 255u) == 0u) { if (xb_ld(&(bar)[XB_TMO])) break; if (_sp > XB_SPIN_CAP) { atomicAdd(&(bar)[XB_TMO], 1u); break; } } } } while (0)
struct XcdBarrier { unsigned* bar; unsigned x; volatile LAS unsigned* st; };
__device__ __forceinline__ XcdBarrier xcd_barrier_post(unsigned* bar, volatile LAS unsigned* st) {
    XcdBarrier b; b.bar = bar; b.x = xb_xcc_id(); b.st = st;
    if (threadIdx.x == 0) (void)xb_add(&bar[XB_XCNT(b.x)], 1u);
    return b;
}
__device__ __forceinline__ void xcd_barrier_complete(unsigned* bar, unsigned x, unsigned& nloc, unsigned& nx) {
    const unsigned G = gridDim.x * gridDim.y * gridDim.z;
    unsigned sum, cnt, mine, sp = 0u;
    for (;;) {
        sum = 0u; cnt = 0u; mine = 0u;
#pragma unroll
        for (unsigned j = 0; j < 16; ++j) { const unsigned c = xb_ld(&bar[XB_XCNT(j)]); sum += c; cnt += (c > 0u) ? 1u : 0u; mine = (j == x) ? c : mine; }
        if (sum == G) break;
        __builtin_amdgcn_s_sleep(1);
        if ((++sp & 255u) == 0u) { if (xb_ld(&bar[XB_TMO])) break; if (sp > XB_SPIN_CAP) { atomicAdd(&bar[XB_TMO], 1u); break; } }
    }
    nloc = mine > 0u ? mine : 1u; nx = cnt > 0u ? cnt : 1u;
}
__device__ __forceinline__ void xcd_barrier(const XcdBarrier& b) {
    asm volatile("s_waitcnt vmcnt(0)" ::: "memory");
    __syncthreads();
    if (threadIdx.x == 0) {
        unsigned* bar = b.bar;
        __builtin_amdgcn_s_waitcnt(0);
        unsigned nloc = b.st[0], nx = b.st[1];
        if (nloc == 0u) { xcd_barrier_complete(bar, b.x, nloc, nx); b.st[0] = nloc; b.st[1] = nx; }
        const unsigned old = xb_add(&bar[XB_XSUB(b.x)], 1u);
        const unsigned gen = old / nloc;
        if (old + 1u == (gen + 1u) * nloc) {
            __builtin_amdgcn_fence(__ATOMIC_RELEASE, "agent");
            asm volatile("s_waitcnt vmcnt(0)" ::: "memory");
            const unsigned og = xb_add(&bar[XB_TOP], 1u);
            const unsigned tg = og / nx;
            if (og + 1u == (tg + 1u) * nx) xb_add(&bar[XB_TOPGEN], 1u);
            else XB_SPIN(xb_ld(&bar[XB_TOPGEN]) == tg, bar);
            __builtin_amdgcn_fence(__ATOMIC_ACQUIRE, "agent");
            xb_add(&bar[XB_XGEN(b.x)], 1u);
            asm volatile("s_waitcnt vmcnt(0)" ::: "memory");
        } else {
            XB_SPIN(xb_ld(&bar[XB_XGEN(b.x)]) == gen, bar);
            __builtin_amdgcn_fence(__ATOMIC_ACQUIRE, "agent");
            asm volatile("s_waitcnt vmcnt(0)" ::: "memory");
        }
    }
    __syncthreads();
}

struct Args { const float* in[23]; float* out; unsigned char* ws; int ph_lo, ph_hi; };
struct Frame {
    LAS unsigned char* lds;
    int tid, lane, wave, G, bid;
    __device__ __forceinline__ void fresh() { int t = threadIdx.x; asm volatile("" : "+v"(t)); tid = t; lane = t & 63; }
    float* out; unsigned char* ws;
};
__device__ __forceinline__ const float* inptr(int i) { const __attribute__((address_space(4))) Args* a = (const __attribute__((address_space(4))) Args*)__builtin_amdgcn_kernarg_segment_ptr(); asm volatile("" : "+s"(a)); return a->in[i]; }
#define INP(i) inptr(i)
enum { I_X = 0, I_C, I_WADA, I_BADA, I_N1G, I_WIN, I_WA2, I_BA, I_GLANG, I_HGNG, I_LB, I_WOUT, I_N2G, I_WRG, I_BRG, I_WRE, I_BRE, I_WEG, I_WEU, I_WED, I_WADAF, I_BADAF, I_NFG };


namespace pg8 {
typedef short bf16x8 __attribute__((ext_vector_type(8)));
constexpr int BM = 256, BK = 64, HALF = 128, HTB = HALF * BK * 2, STAGE_BYTES = 8 * HTB, NXCD = 8, WGM = 8;
__host__ __device__ __forceinline__ int lds_byte(int r, int c) { const int st = (r >> 4) * 2 + (c >> 5), rr = r & 15, cc = c & 31, ob = rr * 64 + cc * 2; return st * 1024 + (ob ^ (((ob >> 9) & 1) << 5)); }
__host__ __device__ __forceinline__ void stage_rc(int b, int& R, int& C) { const int st = b / 1024, sb = b % 1024, swz = sb ^ (((sb >> 9) & 1) << 5); R = (st >> 1) * 16 + swz / 64; C = (st & 1) * 32 + (swz % 64) / 2; }
__host__ __device__ __forceinline__ int perm32(int rho) { const int n = rho >> 4, i = rho & 15; return 8 * (i >> 2) + 4 * n + (i & 3); }
__device__ __forceinline__ unsigned cvt_pk_bf16(float lo, float hi) { unsigned r; asm volatile("v_cvt_pk_bf16_f32 %0, %1, %2" : "=v"(r) : "v"(lo), "v"(hi)); return r; }

struct UnitG { const char* A; const char* B; int id0, id1, id2, id3; };

struct GridOrder {
    int nM, nN, nwg, G, c;
    __device__ __forceinline__ void init(int nM_, int nN_, int G_, int c_) { nM = nM_; nN = nN_; nwg = nM * nN; G = G_; c = c_; }
    __device__ __forceinline__ bool tile(int i, int& pm, int& pn) const {
        const long L = (long)i * G + c; if (L >= nwg) return false;
        int wgid = (int)L; { const int q = nwg / NXCD, r = nwg % NXCD, xcd = wgid % NXCD, off = wgid / NXCD; wgid = (xcd < r ? xcd * (q + 1) : r * (q + 1) + (xcd - r) * q) + off; }
        const int nig = WGM * nN, gid = wgid / nig, fm = gid * WGM, gsz = (nM - fm) < WGM ? (nM - fm) : WGM;
        pm = fm + ((wgid % nig) % gsz); pn = (wgid % nig) / gsz; return true;
    }
};
struct DenseSched {
    GridOrder o; const char* A; const char* Bt; size_t tstep;
    __device__ __forceinline__ bool next(int i, UnitG& u) const { int pm, pn; if (!o.tile(i, pm, pn)) return false; u.A = A + (size_t)pm * tstep; u.B = Bt + (size_t)pn * tstep; u.id0 = pm; u.id1 = pn; u.id2 = 0; u.id3 = 0; return true; }
    __device__ __forceinline__ unsigned row_of(const UnitG&, int r) const { return (unsigned)r; }
};

template <class Epi, class Sched, bool ALIGN_EPI>
__device__ __forceinline__ void gemm_phase(LAS unsigned char* lds, const int K, const Sched& S, const Epi& E) {
    int tid = threadIdx.x; asm volatile("" : "+v"(tid));
    const int wid = __builtin_amdgcn_readfirstlane(tid >> 6), lane = tid & 63, wr = wid >> 2, wc = wid & 3, fr = lane & 15, fq = lane >> 4;
    const int nt = K / BK;
    int Rr[2], Cc[2]; unsigned voffB[2];
#pragma unroll
    for (int i = 0; i < 2; ++i) { stage_rc(tid * 16 + i * 8192, Rr[i], Cc[i]); const int Rb = Epi::PERM ? ((Rr[i] & ~31) + perm32(Rr[i] & 31)) : Rr[i]; voffB[i] = (unsigned)(Rb * K + Cc[i]) * 2u; }
    const size_t kstep = (size_t)(BK * 2);
    const size_t hstep = (size_t)HALF * K * 2;
    const unsigned ldsw = (unsigned)wid * 1024u;
    const int aoff = lds_byte(wr * 64 + fr, fq * 8), boff = lds_byte(wc * 32 + fr, fq * 8);
#define PG8_SA(b, h) (((b) * 2 + (h)) * HTB)
#define PG8_SB(b, h) ((4 + (b) * 2 + (h)) * HTB)
#define PG8_STAGE(bufoff, gbase, voff) do { _Pragma("unroll") for (int _i = 0; _i < 2; ++_i) \
        __builtin_amdgcn_global_load_lds((const unsigned*)((const char*)(gbase) + (voff)[_i]), (LAS unsigned*)(lds + (bufoff) + ldsw + _i * 8192), 16, 0, 0); } while (0)
#define PG8_LDA(dst, b, h) do { _Pragma("unroll") for (int m = 0; m < 4; ++m) _Pragma("unroll") for (int k = 0; k < 2; ++k) dst[m][k] = *(const LAS bf16x8*)(lds + PG8_SA(b, h) + aoff + m * 2048 + k * 1024); } while (0)
#define PG8_LDB(dst, b, h) do { _Pragma("unroll") for (int n = 0; n < 2; ++n) _Pragma("unroll") for (int k = 0; k < 2; ++k) dst[n][k] = *(const LAS bf16x8*)(lds + PG8_SB(b, h) + boff + n * 2048 + k * 1024); } while (0)
#define PG8_MMA(ai, bj, At, Bt) do { __builtin_amdgcn_s_setprio(1); _Pragma("unroll") for (int m = 0; m < 4; ++m) _Pragma("unroll") for (int n = 0; n < 2; ++n) _Pragma("unroll") for (int k = 0; k < 2; ++k) \
        acc[ai][bj][m][n] = __builtin_amdgcn_mfma_f32_16x16x32_bf16(Bt[n][k], At[m][k], acc[ai][bj][m][n], 0, 0, 0); __builtin_amdgcn_s_setprio(0); } while (0)
#define PG8_WAIT_V(n) asm volatile("s_waitcnt vmcnt(" #n ")" ::: "memory")
#define PG8_WAIT_L(n) asm volatile("s_waitcnt lgkmcnt(" #n ")" ::: "memory")
#define PG8_BAR __builtin_amdgcn_s_barrier()
#define PG8_SCHED __builtin_amdgcn_sched_barrier(0)
#define PG8_VOFFS(dst, u) do { _Pragma("unroll") for (int _h = 0; _h < 2; ++_h) _Pragma("unroll") for (int _i = 0; _i < 2; ++_i) dst[_h][_i] = (S.row_of(u, _h * HALF + Rr[_i]) * (unsigned)K + (unsigned)Cc[_i]) * 2u; } while (0)
    UnitG cur, nxt; int ui = 0;
    if (!S.next(0, cur)) return;
    f32x4 acc[2][2][4][2];
#pragma unroll
    for (int a = 0; a < 2; ++a)
#pragma unroll
        for (int b = 0; b < 2; ++b)
#pragma unroll
            for (int m = 0; m < 4; ++m)
#pragma unroll
                for (int n = 0; n < 2; ++n) acc[a][b][m][n] = (f32x4){0.f, 0.f, 0.f, 0.f};
    bf16x8 At[4][2], B0[2][2], B1[2][2];
    unsigned cva[2][2];
    PG8_VOFFS(cva, cur);
    const char* cA = cur.A; const char* cB = cur.B;
    PG8_STAGE(PG8_SB(0, 0), cB, voffB); PG8_STAGE(PG8_SB(0, 1), cB + hstep, voffB); PG8_STAGE(PG8_SA(0, 0), cA, cva[0]); PG8_STAGE(PG8_SA(0, 1), cA, cva[1]);
    if (wr == 1) PG8_BAR;
    PG8_WAIT_V(2); PG8_BAR;
    PG8_STAGE(PG8_SB(1, 0), cB + kstep, voffB); PG8_STAGE(PG8_SA(1, 0), cA + kstep, cva[0]); PG8_STAGE(PG8_SB(1, 1), cB + hstep + kstep, voffB);
    PG8_WAIT_V(6); PG8_BAR;
    for (;;) {
        const bool has_next = S.next(ui + 1, nxt);
        const char* nA = has_next ? nxt.A : cA; const char* nB = has_next ? nxt.B : cB;
#pragma unroll 1
        for (int t = 0; t < nt; t += 2) {
            const bool last = (t == nt - 2);
            const char* a1 = cA + (size_t)(t + 1) * kstep;
            const char* a2 = last ? nA : cA + (size_t)(t + 2) * kstep; const char* b2 = last ? nB : cB + (size_t)(t + 2) * kstep;
            const char* a3 = a2 + kstep; const char* b3 = b2 + kstep;
            PG8_LDB(B0, 0, 0); PG8_LDB(B1, 0, 1); PG8_SCHED; PG8_LDA(At, 0, 0); PG8_STAGE(PG8_SA(1, 1), a1, cva[1]);
            if (last && has_next) { PG8_VOFFS(cva, nxt); }
            PG8_WAIT_V(8); PG8_WAIT_L(0); PG8_BAR; PG8_MMA(0, 0, At, B0); PG8_MMA(0, 1, At, B1); PG8_BAR; PG8_SCHED;
            PG8_LDA(At, 0, 1); PG8_STAGE(PG8_SB(0, 0), b2, voffB); PG8_STAGE(PG8_SB(0, 1), b2 + hstep, voffB); PG8_STAGE(PG8_SA(0, 0), a2, cva[0]);
            PG8_WAIT_V(8); PG8_WAIT_L(0); PG8_BAR; PG8_MMA(1, 0, At, B0); PG8_MMA(1, 1, At, B1); PG8_BAR; PG8_SCHED;
            PG8_LDB(B0, 1, 0); PG8_LDB(B1, 1, 1); PG8_SCHED; PG8_LDA(At, 1, 0); PG8_STAGE(PG8_SA(0, 1), a2, cva[1]);
            PG8_WAIT_V(8); PG8_WAIT_L(0); PG8_BAR; PG8_MMA(0, 0, At, B0); PG8_MMA(0, 1, At, B1); PG8_BAR; PG8_SCHED;
            PG8_LDA(At, 1, 1); PG8_STAGE(PG8_SB(1, 0), b3, voffB); PG8_STAGE(PG8_SB(1, 1), b3 + hstep, voffB); PG8_STAGE(PG8_SA(1, 0), a3, cva[0]);
            PG8_WAIT_V(8); PG8_WAIT_L(0); PG8_BAR; PG8_MMA(1, 0, At, B0); PG8_MMA(1, 1, At, B1); PG8_BAR; PG8_SCHED;
        }
        if constexpr (ALIGN_EPI) { if (wr == 0) PG8_BAR; }
        E(acc, cur, wr, wc, fr, fq);
        if (!has_next) break;
#pragma unroll
        for (int a = 0; a < 2; ++a)
#pragma unroll
            for (int b = 0; b < 2; ++b)
#pragma unroll
                for (int m = 0; m < 4; ++m)
#pragma unroll
                    for (int n = 0; n < 2; ++n) acc[a][b][m][n] = (f32x4){0.f, 0.f, 0.f, 0.f};
        cur = nxt; cA = nA; cB = nB; ++ui;
        if constexpr (ALIGN_EPI) { if (wr == 1) PG8_BAR; }
    }
    PG8_WAIT_V(0);
    if constexpr (!ALIGN_EPI) { if (wr == 0) PG8_BAR; }
    PG8_BAR;
#undef PG8_SA
#undef PG8_SB
#undef PG8_STAGE
#undef PG8_LDA
#undef PG8_LDB
#undef PG8_MMA
#undef PG8_WAIT_V
#undef PG8_WAIT_L
#undef PG8_BAR
#undef PG8_SCHED
#undef PG8_VOFFS
}

struct EpiProj {
    static constexpr bool PERM = true;
    bf16* O; int ldc;
    __device__ __forceinline__ void operator()(const f32x4 (&acc)[2][2][4][2], const UnitG& u, int wr, int wc, int fr, int fq) const {
        const int row0 = u.id0 * BM + wr * 64 + fr, col0 = u.id1 * BM + wc * 32 + 8 * fq;
#pragma unroll
        for (int ai = 0; ai < 2; ++ai)
#pragma unroll
            for (int m = 0; m < 4; ++m) { bf16* rowp = O + (size_t)(row0 + ai * HALF + m * 16) * ldc + col0;
#pragma unroll
                for (int bj = 0; bj < 2; ++bj) { const f32x4 v0 = acc[ai][bj][m][0], v1 = acc[ai][bj][m][1];
                    v4u w; w.x = cvt_pk_bf16(v0[0], v0[1]); w.y = cvt_pk_bf16(v0[2], v0[3]); w.z = cvt_pk_bf16(v1[0], v1[1]); w.w = cvt_pk_bf16(v1[2], v1[3]);
                    *(v4u*)(rowp + bj * HALF) = w; } }
    }
};
struct EpiX1 {
    static constexpr bool PERM = false;
    const float* x; const float* mod; float* out;
    __device__ __forceinline__ void operator()(const f32x4 (&acc)[2][2][4][2], const UnitG& u, int wr, int wc, int fr, int fq) const {
        const int row0 = u.id0 * BM + wr * 64 + fr, col0 = u.id1 * BM + wc * 32 + 4 * fq;
        const float* gt = mod + (size_t)(u.id0 / 8) * NMOD + 2048;
        f32x4 gv[2][2];
#pragma unroll
        for (int bj = 0; bj < 2; ++bj)
#pragma unroll
            for (int n = 0; n < 2; ++n) gv[bj][n] = *(const f32x4*)(gt + col0 + bj * HALF + n * 16);
#pragma unroll
        for (int ai = 0; ai < 2; ++ai)
#pragma unroll
            for (int m = 0; m < 4; ++m) { const size_t off = (size_t)(row0 + ai * HALF + m * 16) * D + col0;
#pragma unroll
                for (int bj = 0; bj < 2; ++bj)
#pragma unroll
                    for (int n = 0; n < 2; ++n) { const f32x4 xv = *(const f32x4*)(x + off + bj * HALF + n * 16); *(f32x4*)(out + off + bj * HALF + n * 16) = xv + gv[bj][n] * acc[ai][bj][m][n]; }
                if (m & 1) asm volatile("" ::: "memory"); }
    }
};
}

__device__ __forceinline__ void transpose_item(const float* W, size_t ldw, bf16* WT, size_t ldt, LAS float* scr, int lane) {
#pragma unroll 8
    for (int i = 0; i < 32; ++i) { const int kk = 2 * i + (lane >> 5); scr[kk * 33 + (lane & 31)] = W[(size_t)kk * ldw + (lane & 31)]; }
    LDS_WAIT(); asm volatile("" ::: "memory");
    const int c = lane & 7;
#pragma unroll
    for (int j = 0; j < 4; ++j) { const int n = (lane >> 3) + 8 * j; const LAS float* s = scr + (8 * c) * 33 + n;
        v4u o; o.x = pk2(s[0 * 33], s[1 * 33]); o.y = pk2(s[2 * 33], s[3 * 33]); o.z = pk2(s[4 * 33], s[5 * 33]); o.w = pk2(s[6 * 33], s[7 * 33]);
        *(v4u*)(WT + (size_t)n * ldt + 8 * c) = o; }
    LDS_WAIT(); asm volatile("" ::: "memory");
}

__device__ __forceinline__ void phase_prologue(Frame& F) {
    const float* w_in = INP(I_WIN); const float* w_out = INP(I_WOUT);
    bf16* Win_t = (bf16*)(F.ws + WS_WIN); bf16* Wout_t = (bf16*)(F.ws + WS_WOUT); bf16* Wup_t = (bf16*)(F.ws + WS_WUP); bf16* Wdn_t = (bf16*)(F.ws + WS_WDN);
    LAS float* scr = (LAS float*)(F.lds + F.wave * 16384);
    const int gw = F.bid * 8 + F.wave, NGW = F.G * 8;
    constexpr int I_A = 16 * 112, I_B = 16 * 32, I_E = 32 * 128;
    constexpr int NITEMS = I_A + I_B + 3 * I_E;
    for (int it = gw; it < NITEMS; it += NGW) {
        int r = it;
        if (r < I_A) { const int kb = r / 112, nb = r % 112, n0 = 32 * nb, src = n0 < 1536 ? n0 : n0 + 16;
            transpose_item(w_in + (size_t)(64 * kb) * IN_COLS + src, IN_COLS, Win_t + (size_t)n0 * D + 64 * kb, D, scr, F.lane); continue; }
        r -= I_A;
        if (r < I_B) { const int kb = r / 32, nb = r % 32;
            transpose_item(w_out + (size_t)(64 * kb) * D + 32 * nb, D, Wout_t + (size_t)(32 * nb) * D + 64 * kb, D, scr, F.lane); continue; }
        r -= I_B;
        if (r < 2 * I_E) { const int up = r >= I_E; if (up) r -= I_E; const int e = r / 128, q = r % 128, kb = q / 8, nb = q % 8, f0 = 32 * nb;
            const int drow = (f0 / 128) * 256 + (f0 % 128) + (up ? 128 : 0);
            const float* W = (up ? INP(I_WEU) : INP(I_WEG)) + (size_t)e * D * FF + (size_t)(64 * kb) * FF + f0;
            transpose_item(W, FF, Wup_t + ((size_t)e * 512 + drow) * D + 64 * kb, D, scr, F.lane); continue; }
        r -= 2 * I_E;
        { const int e = r / 128, q = r % 128, kb = q / 32, nb = q % 32;
            transpose_item(INP(I_WED) + (size_t)e * FF * D + (size_t)(64 * kb) * D + 32 * nb, D, Wdn_t + ((size_t)e * D + 32 * nb) * FF + 64 * kb, FF, scr, F.lane); }
    }
    {
        const float* wa2 = INP(I_WA2);
        for (int idx = F.bid * 512 + F.tid; idx < 256 * D; idx += F.G * 512) {
            const int j = idx / D, k = idx % D; float s = 0.f;
#pragma unroll
            for (int r = 0; r < 16; ++r) s += w_in[(size_t)k * IN_COLS + 1536 + r] * wa2[r * 256 + j];
            Win_t[(size_t)(C_AL + j) * D + k] = (bf16)f2bf(s);
        }
    }
    __syncthreads();
    {
        LAS float* cact = (LAS float*)F.lds;
        LAS float* red = (LAS float*)(F.lds + 65536);
        const float* c = INP(I_C);
        for (int i = F.tid; i < NB * D; i += 512) { const int b = i / D, k = i % D; cact[k * 16 + b] = siluf_(c[i]); }
        __syncthreads();
        float* mod = (float*)(F.ws + WS_MOD);
        for (int cb = F.bid; cb < NMOD / 32; cb += F.G) {
            const int n = cb * 32 + (F.lane & 31);
            const float* W; size_t ldw;
            if (n < 6144) { W = INP(I_WADA) + n; ldw = 6144; } else { W = INP(I_WADAF) + (n - 6144); ldw = 2048; }
            float acc[16];
#pragma unroll
            for (int b = 0; b < 16; ++b) acc[b] = 0.f;
            for (int i = 0; i < 64; ++i) {
                const int k = 128 * F.wave + 2 * i + (F.lane >> 5);
                const float w = W[(size_t)k * ldw];
                const LAS f32x4* cp = (const LAS f32x4*)(cact + k * 16);
#pragma unroll
                for (int q = 0; q < 4; ++q) { const f32x4 cv = cp[q]; acc[4 * q + 0] += cv.x * w; acc[4 * q + 1] += cv.y * w; acc[4 * q + 2] += cv.z * w; acc[4 * q + 3] += cv.w * w; }
            }
#pragma unroll
            for (int b = 0; b < 16; ++b) acc[b] += __shfl_xor(acc[b], 32);
            if (F.lane < 32) {
#pragma unroll
                for (int b = 0; b < 16; ++b) red[(F.wave * 16 + b) * 32 + F.lane] = acc[b];
            }
            __syncthreads();
            { const int b = F.tid >> 5, cc = F.tid & 31; float s = 0.f;
#pragma unroll
                for (int w = 0; w < 8; ++w) s += red[(w * 16 + b) * 32 + cc];
                const int nn = cb * 32 + cc; const float bb = nn < 6144 ? INP(I_BADA)[nn] : INP(I_BADAF)[nn - 6144];
                mod[(size_t)b * NMOD + nn] = s + bb; }
            __syncthreads();
        }
    }
}

__device__ __forceinline__ void load_row16(const float* p, int lane, f32x4 (&v)[4]) {
    const f32x4* r = (const f32x4*)p + lane;
#pragma unroll
    for (int j = 0; j < 4; ++j) v[j] = r[64 * j];
}
__device__ __forceinline__ float sumsq16(const f32x4 (&v)[4]) {
    float s = 0.f;
#pragma unroll
    for (int j = 0; j < 4; ++j) s += (v[j].x * v[j].x + v[j].y * v[j].y) + (v[j].z * v[j].z + v[j].w * v[j].w);
    return s;
}
__device__ __forceinline__ void store_row16_bf16(bf16* p, int lane, const f32x4 (&v)[4]) {
    v2u* o = (v2u*)p + lane;
#pragma unroll
    for (int j = 0; j < 4; ++j) { v2u w; w.x = pk2(v[j].x, v[j].y); w.y = pk2(v[j].z, v[j].w); o[64 * j] = w; }
}
__device__ __forceinline__ void norm_mod16(f32x4 (&v)[4], float r, const float* g, const float* sc, const float* sh, int lane) {
    f32x4 gv[4], scv[4], shv[4]; load_row16(g, lane, gv); load_row16(sc, lane, scv); load_row16(sh, lane, shv);
#pragma unroll
    for (int j = 0; j < 4; ++j) v[j] = v[j] * r * gv[j] * (1.0f + scv[j]) + shv[j];
}

__device__ __forceinline__ void phase_norm1(Frame& F) {
    const float* x = INP(I_X); const float* mod = (const float*)(F.ws + WS_MOD); bf16* h = (bf16*)(F.ws + WS_R2);
    const int gw = F.bid * 8 + F.wave, NGW = F.G * 8;
    for (int m = gw; m < M; m += NGW) {
        const int b = m / SEQ; f32x4 v[4]; load_row16(x + (size_t)m * D, F.lane, v);
        const float r = 1.0f / sqrtf(wave_sum(sumsq16(v)) * (1.0f / D) + EPS);
        norm_mod16(v, r, INP(I_N1G), mod + (size_t)b * NMOD + 1024, mod + (size_t)b * NMOD, F.lane);
        store_row16_bf16(h + (size_t)m * D, F.lane, v);
    }
}

__device__ __forceinline__ void naive_tile(LAS unsigned char* lds, const bf16* A, size_t lda, const LAS int* rowidx, const bf16* Bt, size_t ldb, int K, int tid, float (&acc)[4][8]) {
    LAS float* As = (LAS float*)lds;
    LAS float* Bs = (LAS float*)(lds + 32 * 132 * 4);
    const int ty = tid >> 4, tx = tid & 15;
    const int lr = tid >> 2, kp = (tid & 3) * 8;
    const size_t arow = rowidx ? (size_t)rowidx[lr] : (size_t)lr;
    for (int k0 = 0; k0 < K; k0 += 32) {
        const v4u av = *(const v4u*)(A + arow * lda + k0 + kp);
        const v4u bv = *(const v4u*)(Bt + (size_t)lr * ldb + k0 + kp);
        __syncthreads();
        As[(kp + 0) * 132 + lr] = bflo(av.x); As[(kp + 1) * 132 + lr] = bfhi(av.x); As[(kp + 2) * 132 + lr] = bflo(av.y); As[(kp + 3) * 132 + lr] = bfhi(av.y);
        As[(kp + 4) * 132 + lr] = bflo(av.z); As[(kp + 5) * 132 + lr] = bfhi(av.z); As[(kp + 6) * 132 + lr] = bflo(av.w); As[(kp + 7) * 132 + lr] = bfhi(av.w);
        Bs[(kp + 0) * 132 + lr] = bflo(bv.x); Bs[(kp + 1) * 132 + lr] = bfhi(bv.x); Bs[(kp + 2) * 132 + lr] = bflo(bv.y); Bs[(kp + 3) * 132 + lr] = bfhi(bv.y);
        Bs[(kp + 4) * 132 + lr] = bflo(bv.z); Bs[(kp + 5) * 132 + lr] = bfhi(bv.z); Bs[(kp + 6) * 132 + lr] = bflo(bv.w); Bs[(kp + 7) * 132 + lr] = bfhi(bv.w);
        __syncthreads();
#pragma unroll 4
        for (int kk = 0; kk < 32; ++kk) {
            const f32x4 a = *(const LAS f32x4*)(As + kk * 132 + ty * 4);
            const f32x4 b0 = *(const LAS f32x4*)(Bs + kk * 132 + tx * 8), b1 = *(const LAS f32x4*)(Bs + kk * 132 + tx * 8 + 4);
            const float av4[4] = {a.x, a.y, a.z, a.w}; const float bv8[8] = {b0.x, b0.y, b0.z, b0.w, b1.x, b1.y, b1.z, b1.w};
#pragma unroll
            for (int i = 0; i < 4; ++i)
#pragma unroll
                for (int j = 0; j < 8; ++j) acc[i][j] += av4[i] * bv8[j];
        }
    }
    __syncthreads();
}
#define ZERO_ACC(acc) do { _Pragma("unroll") for (int _i = 0; _i < 4; ++_i) _Pragma("unroll") for (int _j = 0; _j < 8; ++_j) acc[_i][_j] = 0.f; } while (0)

__device__ __forceinline__ void phase_gemm1_naive(Frame& F) {
    const bf16* h = (const bf16*)(F.ws + WS_R2); const bf16* Wt = (const bf16*)(F.ws + WS_WIN); bf16* proj = (bf16*)(F.ws + WS_R1);
    const int ty = F.tid >> 4, tx = F.tid & 15;
    constexpr int NTN = NP / 128, NT = (M / 128) * NTN;
    for (int t = F.bid; t < NT; t += F.G) {
        const int tm = t / NTN, tn = t % NTN; float acc[4][8]; ZERO_ACC(acc);
        naive_tile(F.lds, h + (size_t)tm * 128 * D, D, nullptr, Wt + (size_t)tn * 128 * D, D, D, F.tid, acc);
#pragma unroll
        for (int i = 0; i < 4; ++i) { v4u o; o.x = pk2(acc[i][0], acc[i][1]); o.y = pk2(acc[i][2], acc[i][3]); o.z = pk2(acc[i][4], acc[i][5]); o.w = pk2(acc[i][6], acc[i][7]);
            *(v4u*)(proj + (size_t)(tm * 128 + ty * 4 + i) * NP + tn * 128 + tx * 8) = o; }
    }
}


__device__ __forceinline__ void phase_gemm1_fast(Frame& F) {
    pg8::DenseSched S; S.o.init(M / 256, NP / 256, F.G, F.bid); S.A = (const char*)(F.ws + WS_R2); S.Bt = (const char*)(F.ws + WS_WIN); S.tstep = (size_t)256 * D * 2;
    pg8::EpiProj E{(bf16*)(F.ws + WS_R1), NP};
    pg8::gemm_phase<pg8::EpiProj, pg8::DenseSched, true>(F.lds, D, S, E);
}
__device__ __forceinline__ void phase_gemm_out_fast(Frame& F) {
    pg8::DenseSched S; S.o.init(M / 256, D / 256, F.G, F.bid); S.A = (const char*)(F.ws + WS_R2); S.Bt = (const char*)(F.ws + WS_WOUT); S.tstep = (size_t)256 * D * 2;
    pg8::EpiX1 E{INP(I_X), (const float*)(F.ws + WS_MOD), F.out};
    pg8::gemm_phase<pg8::EpiX1, pg8::DenseSched, true>(F.lds, D, S, E);
}

__device__ __forceinline__ void phase_scan_naive(Frame& F) {
    const bf16* proj = (const bf16*)(F.ws + WS_R1); bf16* o = (bf16*)(F.ws + WS_R2);
    LAS float* gA = (LAS float*)F.lds;
    LAS float* gK = gA + 16 * 128;
    LAS float* gQ = gK + 16 * 128;
    LAS float* part = gQ + 16 * 128;
    const int c = F.tid & 127, kq = F.tid >> 7;
    for (int u = F.bid; u < NB * 8; u += F.G) {
        const int b = u >> 3, hh = u & 7; const bool gla = hh < 4; const int hd = hh & 3;
        const int dk = gla ? 64 : 128, kper = dk / 4;
        float Sreg[32];
#pragma unroll
        for (int i = 0; i < 32; ++i) Sreg[i] = 0.f;
        const int vcol = gla ? C_GV + hd * 128 : C_HI + hd * 128;
        const int gcol = gla ? C_GG + hd * 128 : C_HG + hd * 128;
        const float* ng = gla ? INP(I_GLANG) : INP(I_HGNG);
        for (int t0 = 0; t0 < SEQ; t0 += 16) {
            __syncthreads();
            for (int i = F.tid; i < 16 * dk; i += 512) {
                const int r = i / dk, k = i % dk; const size_t m = (size_t)b * SEQ + t0 + r; const bf16* pr = proj + m * NP;
                float a, kk, qq;
                if (gla) { const float al = bf2f(pr[C_AL + hd * 64 + k]) + INP(I_BA)[hd * 64 + k];
                    const float ls = fminf(al, 0.f) - log1pf(__expf(-fabsf(al)));
                    a = __expf(ls * (1.0f / 16.0f)); kk = bf2f(pr[C_GK + hd * 64 + k]); qq = bf2f(pr[C_GQ + hd * 64 + k]) * 0.125f; }
                else { const int j = hd * 128 + k; const float l0 = INP(I_LB)[j], l1 = INP(I_LB)[512 + j]; const float lb = 1.0f / (1.0f + __expf(l1 - l0));
                    const float f = lb + (1.0f - lb) * sigmoidf_(bf2f(pr[C_HF + j]));
                    a = f; kk = 1.0f - f; qq = bf2f(pr[C_HQ + j]) * 0.08838834764831845f; }
                gA[r * 128 + k] = a; gK[r * 128 + k] = kk; gQ[r * 128 + k] = qq;
            }
            __syncthreads();
            for (int r = 0; r < 16; ++r) {
                const size_t m = (size_t)b * SEQ + t0 + r; const float v = bf2f(proj[m * NP + vcol + c]); float po = 0.f;
#pragma unroll
                for (int i = 0; i < 32; ++i) { if (i < kper) { const int k = kq * kper + i; Sreg[i] = gA[r * 128 + k] * Sreg[i] + gK[r * 128 + k] * v; po += gQ[r * 128 + k] * Sreg[i]; } }
                part[(r * 4 + kq) * 128 + c] = po;
            }
            __syncthreads();
            { const int r = F.tid >> 5, c4 = (F.tid & 31) * 4; const size_t m = (size_t)b * SEQ + t0 + r;
                float ov[4]; float ss = 0.f;
#pragma unroll
                for (int e = 0; e < 4; ++e) { ov[e] = part[(r * 4 + 0) * 128 + c4 + e] + part[(r * 4 + 1) * 128 + c4 + e] + part[(r * 4 + 2) * 128 + c4 + e] + part[(r * 4 + 3) * 128 + c4 + e]; ss += ov[e] * ov[e]; }
#pragma unroll
                for (int off = 1; off < 32; off <<= 1) ss += __shfl_xor(ss, off);
                const float rr = 1.0f / sqrtf(ss * (1.0f / 128.0f) + EPS);
                const v2u gw = *(const v2u*)(proj + m * NP + gcol + c4);
                const float g4[4] = {bflo(gw.x), bfhi(gw.x), bflo(gw.y), bfhi(gw.y)}; float res[4];
#pragma unroll
                for (int e = 0; e < 4; ++e) res[e] = ov[e] * rr * ng[c4 + e] * siluf_(g4[e]);
                v2u w; w.x = pk2(res[0], res[1]); w.y = pk2(res[2], res[3]);
                *(v2u*)(o + m * D + hh * 128 + c4) = w; }
        }
    }
}


namespace scan {
typedef short bf16x8 __attribute__((ext_vector_type(8)));
typedef short bf16x4 __attribute__((ext_vector_type(4)));
constexpr int P72 = 144;
template <int DK> struct L {
    static constexpr int DKP = (DK + 8) * 2;
    static constexpr int NRAW = DK == 64 ? 3 : 2;
    static constexpr int QT = 0, KT = QT + 64 * DKP, KH = KT + 64 * DKP, VT = KH + DK * P72, AM = VT + 128 * P72, RT = AM + 64 * P72,
                         OT = RT + NRAW * DK * P72, SEG = OT + 64 * 132 * 4, DV = SEG + 8 * 128 * 4, END = DV + 128 * 4;
};
static_assert(L<128>::END <= 163840 - 256 && L<64>::END <= 163840 - 256, "scan LDS map");

template <int DK>
__device__ __forceinline__ void unit(LAS unsigned char* lds, const bf16* __restrict__ proj, bf16* __restrict__ o, int b, int hd, int hh,
                                     const float* __restrict__ ba, const float* __restrict__ lbl, const float* __restrict__ ng, int tid) {
    typedef L<DK> Y;
    constexpr bool GLA = DK == 64;
    constexpr int RS = DK / 8;
    constexpr int NKB = DK / 16, NKS = DK / 32;
    const int lane = tid & 63, w = __builtin_amdgcn_readfirstlane(tid >> 6), g = lane >> 4, fr = lane & 15;
    const int qcol = GLA ? C_GQ + hd * 64 : C_HQ + hd * 128;
    const int kcol = C_GK + hd * 64;
    const int fcol = GLA ? C_AL + hd * 64 : C_HF + hd * 128;
    const int vcol = GLA ? C_GV + hd * 128 : C_HI + hd * 128;
    const int gcol = GLA ? C_GG + hd * 128 : C_HG + hd * 128;
    const int gk = tid % DK, sg = tid / DK;
    float cgate;
    if (GLA) cgate = ba[hd * 64 + gk];
    else { const float l0 = lbl[hd * 128 + gk], l1 = lbl[512 + hd * 128 + gk]; cgate = 1.0f / (1.0f + __expf(l1 - l0)); }
    for (int i = tid; i < 64 * P72 / 4; i += 512) ((LAS unsigned*)(lds + Y::AM))[i] = 0u;
    f32x4 S[NKB];
#pragma unroll
    for (int i = 0; i < NKB; ++i) S[i] = (f32x4){0.f, 0.f, 0.f, 0.f};
    v4u pq[DK / 64], pf[DK / 64], pk, pv[2];
    const size_t rowb = (size_t)b * SEQ;
#define SCAN_PREFETCH(c) do { const bf16* pr = proj + (rowb + (size_t)(c) * 64 + lane) * NP; \
        _Pragma("unroll") for (int n = 0; n < DK / 64; ++n) { pq[n] = *(const v4u*)(pr + qcol + 8 * (w + 8 * n)); pf[n] = *(const v4u*)(pr + fcol + 8 * (w + 8 * n)); } \
        if (GLA) pk = *(const v4u*)(pr + kcol + 8 * w); \
        _Pragma("unroll") for (int n = 0; n < 2; ++n) pv[n] = *(const v4u*)(pr + vcol + 8 * (w + 8 * n)); } while (0)
#define SCAN_TWRITE(base, piece, cgi) do { LAS unsigned short* tp = (LAS unsigned short*)(lds + (base) + (8 * (cgi)) * P72 + lane * 2); \
        tp[0 * 72] = (unsigned short)(piece.x & 0xffff); tp[1 * 72] = (unsigned short)(piece.x >> 16); tp[2 * 72] = (unsigned short)(piece.y & 0xffff); tp[3 * 72] = (unsigned short)(piece.y >> 16); \
        tp[4 * 72] = (unsigned short)(piece.z & 0xffff); tp[5 * 72] = (unsigned short)(piece.z >> 16); tp[6 * 72] = (unsigned short)(piece.w & 0xffff); tp[7 * 72] = (unsigned short)(piece.w >> 16); } while (0)
    SCAN_PREFETCH(0);
    __syncthreads();
    for (int c = 0; c < SEQ / 64; ++c) {
#pragma unroll
        for (int n = 0; n < DK / 64; ++n) { SCAN_TWRITE(Y::RT, pq[n], w + 8 * n); SCAN_TWRITE(Y::RT + DK * P72, pf[n], w + 8 * n); }
        if (GLA) SCAN_TWRITE(Y::RT + 2 * DK * P72, pk, w);
#pragma unroll
        for (int n = 0; n < 2; ++n) SCAN_TWRITE(Y::VT, pv[n], w + 8 * n);
        if (c + 1 < SEQ / 64) SCAN_PREFETCH(c + 1);
        __syncthreads();
        float pl[RS], kk[RS], qq[RS];
        {
            unsigned rq[RS / 2], rf[RS / 2], rk[RS / 2];
#pragma unroll
            for (int n = 0; n < RS / 8; ++n) { const v4u a = *(const LAS v4u*)(lds + Y::RT + gk * P72 + (sg * RS + 8 * n) * 2), f = *(const LAS v4u*)(lds + Y::RT + DK * P72 + gk * P72 + (sg * RS + 8 * n) * 2);
                rq[4 * n] = a.x; rq[4 * n + 1] = a.y; rq[4 * n + 2] = a.z; rq[4 * n + 3] = a.w; rf[4 * n] = f.x; rf[4 * n + 1] = f.y; rf[4 * n + 2] = f.z; rf[4 * n + 3] = f.w;
                if (GLA) { const v4u k4 = *(const LAS v4u*)(lds + Y::RT + 2 * DK * P72 + gk * P72 + (sg * RS + 8 * n) * 2); rk[4 * n] = k4.x; rk[4 * n + 1] = k4.y; rk[4 * n + 2] = k4.z; rk[4 * n + 3] = k4.w; } }
            float run = 1.0f;
#pragma unroll
            for (int i = 0; i < RS; ++i) {
                const float qv = (i & 1) ? bfhi(rq[i >> 1]) : bflo(rq[i >> 1]); const float fv = (i & 1) ? bfhi(rf[i >> 1]) : bflo(rf[i >> 1]);
                float alpha;
                if (GLA) { const float al = fv + cgate; const float ls = fminf(al, 0.f) - __logf(1.0f + __expf(-fabsf(al))); alpha = __expf(ls * 0.0625f);
                    kk[i] = (i & 1) ? bfhi(rk[i >> 1]) : bflo(rk[i >> 1]); qq[i] = qv * 0.125f; }
                else { const float sgm = __builtin_amdgcn_rcpf(1.0f + __expf(-fv)); alpha = cgate + (1.0f - cgate) * sgm; kk[i] = 1.0f - alpha; qq[i] = qv * 0.08838834764831845f; }
                run *= alpha; pl[i] = run;
            }
            ((LAS float*)(lds + Y::SEG))[sg * 128 + gk] = run;
        }
        __syncthreads();
        {
            float pin = 1.0f, dtot = 1.0f;
#pragma unroll
            for (int s2 = 0; s2 < 512 / DK; ++s2) { const float t = ((const LAS float*)(lds + Y::SEG))[s2 * 128 + gk]; dtot *= t; pin = s2 < sg ? pin * t : pin; }
            unsigned kh[RS / 2];
#pragma unroll
            for (int i = 0; i < RS; ++i) {
                const float P = pin * pl[i], ip = __builtin_amdgcn_rcpf(P); const float qt = qq[i] * P, kt = kk[i] * ip, kht = kt * dtot;
                const int row = sg * RS + i;
                *(LAS unsigned short*)(lds + Y::QT + row * Y::DKP + gk * 2) = (unsigned short)f2bf(qt);
                *(LAS unsigned short*)(lds + Y::KT + row * Y::DKP + gk * 2) = (unsigned short)f2bf(kt);
                if (i & 1) kh[i >> 1] |= f2bf(kht) << 16; else kh[i >> 1] = f2bf(kht);
            }
#pragma unroll
            for (int n = 0; n < RS / 8; ++n) { v4u o4; o4.x = kh[4 * n]; o4.y = kh[4 * n + 1]; o4.z = kh[4 * n + 2]; o4.w = kh[4 * n + 3]; *(LAS v4u*)(lds + Y::KH + gk * P72 + (sg * RS + 8 * n) * 2) = o4; }
            if (sg == 0) ((LAS float*)(lds + Y::DV))[gk] = dtot;
        }
        __syncthreads();
        {
#pragma unroll
            for (int rep = 0; rep < 2; ++rep) { const int n = w + 8 * rep;
                if (n < 10) { const unsigned nib = (unsigned)((0xCD8E94FA50ull >> (4 * n)) & 15ull); const int jb = nib & 3, ib = nib >> 2;
                    f32x4 acc = (f32x4){0.f, 0.f, 0.f, 0.f};
#pragma unroll
                    for (int s2 = 0; s2 < NKS; ++s2) { const bf16x8 a = *(const LAS bf16x8*)(lds + Y::KT + (16 * jb + fr) * Y::DKP + (32 * s2 + 8 * g) * 2), bb = *(const LAS bf16x8*)(lds + Y::QT + (16 * ib + fr) * Y::DKP + (32 * s2 + 8 * g) * 2);
                        acc = __builtin_amdgcn_mfma_f32_16x16x32_bf16(a, bb, acc, 0, 0, 0); }
                    if (jb == ib) {
#pragma unroll
                        for (int r = 0; r < 4; ++r) acc[r] = (4 * g + r <= fr) ? acc[r] : 0.f; }
                    v2u o2; o2.x = pk2(acc[0], acc[1]); o2.y = pk2(acc[2], acc[3]);
                    *(LAS v2u*)(lds + Y::AM + (16 * ib + fr) * P72 + (16 * jb + 4 * g) * 2) = o2; } }
        }
        f32x4 O[4];
        bf16x8 vb[2];
#pragma unroll
        for (int s2 = 0; s2 < 2; ++s2) vb[s2] = *(const LAS bf16x8*)(lds + Y::VT + (16 * w + fr) * P72 + (32 * s2 + 8 * g) * 2);
        {
            bf16x8 sb[NKS];
#pragma unroll
            for (int s2 = 0; s2 < NKS; ++s2) { v4u t; t.x = pk2(S[2 * s2][0], S[2 * s2][1]); t.y = pk2(S[2 * s2][2], S[2 * s2][3]); t.z = pk2(S[2 * s2 + 1][0], S[2 * s2 + 1][1]); t.w = pk2(S[2 * s2 + 1][2], S[2 * s2 + 1][3]);
                sb[s2] = __builtin_bit_cast(bf16x8, t); }
#pragma unroll
            for (int ib = 0; ib < 4; ++ib) { f32x4 acc = (f32x4){0.f, 0.f, 0.f, 0.f};
#pragma unroll
                for (int s2 = 0; s2 < NKS; ++s2) { const LAS unsigned char* qp = lds + Y::QT + (16 * ib + fr) * Y::DKP + (32 * s2 + 4 * g) * 2;
                    const bf16x4 lo = *(const LAS bf16x4*)qp, hi = *(const LAS bf16x4*)(qp + 32);
                    const bf16x8 a = __builtin_shufflevector(lo, hi, 0, 1, 2, 3, 4, 5, 6, 7);
                    acc = __builtin_amdgcn_mfma_f32_16x16x32_bf16(a, sb[s2], acc, 0, 0, 0); }
                O[ib] = acc; }
#pragma unroll
            for (int kb = 0; kb < NKB; ++kb) { const f32x4 dv = *(const LAS f32x4*)(lds + Y::DV + (16 * kb + 4 * g) * 4); f32x4 acc = S[kb] * dv;
#pragma unroll
                for (int s2 = 0; s2 < 2; ++s2) { const bf16x8 a = *(const LAS bf16x8*)(lds + Y::KH + (16 * kb + fr) * P72 + (32 * s2 + 8 * g) * 2);
                    acc = __builtin_amdgcn_mfma_f32_16x16x32_bf16(a, vb[s2], acc, 0, 0, 0); }
                S[kb] = acc; }
        }
        __syncthreads();
#pragma unroll
        for (int ib = 0; ib < 4; ++ib) {
#pragma unroll
            for (int s2 = 0; s2 < 2; ++s2) { const bf16x8 a = *(const LAS bf16x8*)(lds + Y::AM + (16 * ib + fr) * P72 + (32 * s2 + 8 * g) * 2);
                O[ib] = __builtin_amdgcn_mfma_f32_16x16x32_bf16(a, vb[s2], O[ib], 0, 0, 0); }
#pragma unroll
            for (int r = 0; r < 4; ++r) ((LAS float*)(lds + Y::OT))[(16 * ib + 4 * g + r) * 132 + 16 * w + fr] = O[ib][r];
        }
        __syncthreads();
        {
            const int row = tid >> 3, cg = tid & 7; const size_t m = rowb + (size_t)c * 64 + row;
            const v4u g0 = *(const v4u*)(proj + m * NP + gcol + 16 * cg), g1 = *(const v4u*)(proj + m * NP + gcol + 16 * cg + 8);
            f32x4 ov[4]; float ss = 0.f;
#pragma unroll
            for (int q = 0; q < 4; ++q) { ov[q] = *(const LAS f32x4*)(lds + Y::OT + (row * 132 + 16 * cg + 4 * q) * 4); ss += (ov[q].x * ov[q].x + ov[q].y * ov[q].y) + (ov[q].z * ov[q].z + ov[q].w * ov[q].w); }
            ss += __shfl_xor(ss, 1); ss += __shfl_xor(ss, 2); ss += __shfl_xor(ss, 4);
            const float rr = 1.0f / sqrtf(ss * (1.0f / 128.0f) + EPS);
            const unsigned gw[8] = {g0.x, g0.y, g0.z, g0.w, g1.x, g1.y, g1.z, g1.w};
            unsigned ow[8];
#pragma unroll
            for (int q = 0; q < 4; ++q) { const f32x4 gn = *(const f32x4*)(ng + 16 * cg + 4 * q);
                const float ga = bflo(gw[2 * q]), gb = bfhi(gw[2 * q]), gc = bflo(gw[2 * q + 1]), gd = bfhi(gw[2 * q + 1]);
                const float r0 = ov[q].x * rr * gn.x * ga * __builtin_amdgcn_rcpf(1.0f + __expf(-ga)), r1 = ov[q].y * rr * gn.y * gb * __builtin_amdgcn_rcpf(1.0f + __expf(-gb));
                const float r2 = ov[q].z * rr * gn.z * gc * __builtin_amdgcn_rcpf(1.0f + __expf(-gc)), r3 = ov[q].w * rr * gn.w * gd * __builtin_amdgcn_rcpf(1.0f + __expf(-gd));
                ow[2 * q] = pk2(r0, r1); ow[2 * q + 1] = pk2(r2, r3); }
            v4u o0, o1; o0.x = ow[0]; o0.y = ow[1]; o0.z = ow[2]; o0.w = ow[3]; o1.x = ow[4]; o1.y = ow[5]; o1.z = ow[6]; o1.w = ow[7];
            bf16* op = o + m * D + hh * 128 + 16 * cg; *(v4u*)op = o0; *(v4u*)(op + 8) = o1;
        }
    }
#undef SCAN_PREFETCH
#undef SCAN_TWRITE
}
}
__device__ __forceinline__ void phase_scan_fast(Frame& F) {
    const bf16* proj = (const bf16*)(F.ws + WS_R1); bf16* o = (bf16*)(F.ws + WS_R2);
    for (int u = F.bid; u < NB * 8; u += F.G) {
        const int b = u >> 3, hh = u & 7;
        __syncthreads();
        if (hh < 4) scan::unit<64>(F.lds, proj, o, b, hh, hh, INP(I_BA), INP(I_LB), INP(I_GLANG), F.tid);
        else scan::unit<128>(F.lds, proj, o, b, hh - 4, hh, INP(I_BA), INP(I_LB), INP(I_HGNG), F.tid);
    }
}

__device__ __forceinline__ void phase_gemm_out_naive(Frame& F) {
    const bf16* o = (const bf16*)(F.ws + WS_R2); const bf16* Wt = (const bf16*)(F.ws + WS_WOUT); const float* mod = (const float*)(F.ws + WS_MOD);
    const float* x = INP(I_X);
    const int ty = F.tid >> 4, tx = F.tid & 15;
    constexpr int NTN = D / 128, NT = (M / 128) * NTN;
    for (int t = F.bid; t < NT; t += F.G) {
        const int tm = t / NTN, tn = t % NTN; float acc[4][8]; ZERO_ACC(acc);
        naive_tile(F.lds, o + (size_t)tm * 128 * D, D, nullptr, Wt + (size_t)tn * 128 * D, D, D, F.tid, acc);
#pragma unroll
        for (int i = 0; i < 4; ++i) { const int m = tm * 128 + ty * 4 + i, n0 = tn * 128 + tx * 8, b = m / SEQ;
            const float* gt = mod + (size_t)b * NMOD + 2048 + n0; const float* xr = x + (size_t)m * D + n0; float* orow = F.out + (size_t)m * D + n0;
#pragma unroll
            for (int j = 0; j < 8; ++j) orow[j] = xr[j] + gt[j] * acc[i][j]; }
    }
}

__device__ __forceinline__ void phase_norm2_route(Frame& F) {
    const float* x1 = F.out; const float* mod = (const float*)(F.ws + WS_MOD); bf16* h2 = (bf16*)(F.ws + WS_R2);
    float* tokw = (float*)(F.ws + WS_TOKW); int* list = (int*)(F.ws + WS_LIST); unsigned* gcnt = (unsigned*)(F.ws + WS_CTL) + CW_CNT;
    LAS int* lcnt = (LAS int*)F.lds;
    LAS int* lbase = lcnt + 32;
    LAS int* ebuf = lbase + 32;
    constexpr int CAP = 4096;
    if (F.tid < 32) lcnt[F.tid] = 0;
    __syncthreads();
    const float* wrg = INP(I_WRG); const float* wre = INP(I_WRE);
    int it = 0;
    for (int m = F.bid * 8 + F.wave; m < M; m += F.G * 8, ++it) {
        const int b = m / SEQ; f32x4 v[4]; load_row16(x1 + (size_t)m * D, F.lane, v);
        const float r = 1.0f / sqrtf(wave_sum(sumsq16(v)) * (1.0f / D) + EPS);
        norm_mod16(v, r, INP(I_N2G), mod + (size_t)b * NMOD + 4096, mod + (size_t)b * NMOD + 3072, F.lane);
        store_row16_bf16(h2 + (size_t)m * D, F.lane, v);
        float lg[36];
#pragma unroll
        for (int j = 0; j < 36; ++j) lg[j] = 0.f;
        {
            LAS float* hrow = (LAS float*)(F.lds + 65536) + F.wave * 1024;
#pragma unroll
            for (int j = 0; j < 4; ++j) *(LAS f32x4*)(hrow + 4 * F.lane + 256 * j) = v[j];
            LDS_WAIT();
#pragma unroll 1
            for (int kk = 0; kk < 16; ++kk) {
                const int k = F.lane + 64 * kk; const float hk = hrow[k];
                const f32x4 g4 = *(const f32x4*)(wrg + (size_t)k * 4);
                lg[0] += hk * g4.x; lg[1] += hk * g4.y; lg[2] += hk * g4.z; lg[3] += hk * g4.w;
#pragma unroll
                for (int q = 0; q < 8; ++q) { const f32x4 e4 = *(const f32x4*)(wre + (size_t)k * 32 + 4 * q);
                    lg[4 + 4 * q + 0] += hk * e4.x; lg[4 + 4 * q + 1] += hk * e4.y; lg[4 + 4 * q + 2] += hk * e4.z; lg[4 + 4 * q + 3] += hk * e4.w; }
            }
        }
#pragma unroll
        for (int j = 0; j < 36; ++j) lg[j] = wave_sum(lg[j]);
#pragma unroll
        for (int j = 0; j < 4; ++j) lg[j] += INP(I_BRG)[j];
#pragma unroll
        for (int j = 0; j < 32; ++j) lg[4 + j] += INP(I_BRE)[j];
        int g = 0; float gm = lg[0];
#pragma unroll
        for (int j = 1; j < 4; ++j) if (lg[j] > gm) { gm = lg[j]; g = j; }
        float gs = 0.f;
#pragma unroll
        for (int j = 0; j < 4; ++j) gs += __expf(lg[j] - gm);
        const float gp = 1.0f / gs;
        float sel[8];
#pragma unroll
        for (int i = 0; i < 8; ++i) { sel[i] = lg[4 + i];
#pragma unroll
            for (int gg = 1; gg < 4; ++gg) sel[i] = (g == gg) ? lg[4 + gg * 8 + i] : sel[i]; }
        int i0 = 0; float s0 = sel[0];
#pragma unroll
        for (int i = 1; i < 8; ++i) if (sel[i] > s0) { s0 = sel[i]; i0 = i; }
        int i1 = -1; float s1 = -3.0e38f;
#pragma unroll
        for (int i = 0; i < 8; ++i) if (i != i0 && sel[i] > s1) { s1 = sel[i]; i1 = i; }
        const float e1 = __expf(s1 - s0); const float p0 = 1.0f / (1.0f + e1), p1 = e1 / (1.0f + e1);
        if (F.lane == 0) {
            const int ex0 = g * 8 + i0, ex1 = g * 8 + i1;
            tokw[(size_t)m * 2 + 0] = gp * p0; tokw[(size_t)m * 2 + 1] = gp * p1;
            const int r0 = atomicAdd((int*)(lcnt + ex0), 1); const int r1 = atomicAdd((int*)(lcnt + ex1), 1);
            const int n = (it * 8 + F.wave) * 2;
            if (n + 1 < CAP) { ebuf[2 * n] = m * 2; ebuf[2 * n + 1] = (ex0 << 20) | r0; ebuf[2 * n + 2] = m * 2 + 1; ebuf[2 * n + 3] = (ex1 << 20) | r1; }
        }
    }
    __syncthreads();
    if (F.tid < 32) lbase[F.tid] = (int)atomicAdd(gcnt + F.tid, (unsigned)lcnt[F.tid]);
    __syncthreads();
    const int nrows = (M - F.bid * 8 + F.G * 8 - 1) / (F.G * 8);
    const int nent = nrows * 16 < CAP ? nrows * 16 : CAP;
    for (int n = F.tid; n < nent; n += 512) {
        const int itn = n >> 4, wv = (n >> 1) & 7; const int m = F.bid * 8 + wv + itn * F.G * 8;
        if (m < M) { const int tok2 = ebuf[2 * n], er = ebuf[2 * n + 1]; const int e = er >> 20, rk = er & 0xfffff;
            list[(size_t)e * LIST_CAP + lbase[e] + rk] = tok2; }
    }
}

struct MoeMap { int cnt[NE]; int rowbase[NE]; };
__device__ __forceinline__ void moe_map_build(Frame& F, LAS int* mcnt, LAS int* mbase) {
    const unsigned* gcnt = (const unsigned*)(F.ws + WS_CTL) + CW_CNT;
    __syncthreads();
    if (F.tid == 0) { int acc = 0; for (int e = 0; e < NE; ++e) { const int c = (int)gcnt[e]; mcnt[e] = c; mbase[e] = acc; acc += ((c + 255) / 256) * 256; } }
    __syncthreads();
}

__device__ __forceinline__ void phase_moe_up_naive(Frame& F) {
    const bf16* h2 = (const bf16*)(F.ws + WS_R2); const bf16* Wup = (const bf16*)(F.ws + WS_WUP); bf16* act = (bf16*)(F.ws + WS_ACT);
    const int* list = (const int*)(F.ws + WS_LIST);
    LAS int* mcnt = (LAS int*)(F.lds + 40960); LAS int* mbase = mcnt + 32; LAS int* ridx = mbase + 32;
    moe_map_build(F, mcnt, mbase);
    const int ty = F.tid >> 4, tx = F.tid & 15;
    int total = 0;
    for (int e = 0; e < NE; ++e) total += ((mcnt[e] + 127) / 128) * 2;
    for (int u = F.bid; u < total; u += F.G) {
        int e = 0, rem = u;
        for (; e < NE; ++e) { const int n = ((mcnt[e] + 127) / 128) * 2; if (rem < n) break; rem -= n; }
        const int rt = rem >> 1, fb = rem & 1;
        __syncthreads();
        if (F.tid < 128) { const int r = rt * 128 + F.tid; ridx[F.tid] = r < mcnt[e] ? (list[(size_t)e * LIST_CAP + r] >> 1) : 0; }
        __syncthreads();
        float ag[4][8], au[4][8]; ZERO_ACC(ag); ZERO_ACC(au);
        const bf16* Wg = Wup + ((size_t)e * 512 + fb * 256) * D;
        naive_tile(F.lds, h2, D, ridx, Wg, D, D, F.tid, ag);
        naive_tile(F.lds, h2, D, ridx, Wg + (size_t)128 * D, D, D, F.tid, au);
#pragma unroll
        for (int i = 0; i < 4; ++i) { float r8[8];
#pragma unroll
            for (int j = 0; j < 8; ++j) r8[j] = siluf_(ag[i][j]) * au[i][j];
            v4u o; o.x = pk2(r8[0], r8[1]); o.y = pk2(r8[2], r8[3]); o.z = pk2(r8[4], r8[5]); o.w = pk2(r8[6], r8[7]);
            *(v4u*)(act + (size_t)(mbase[e] + rt * 128 + ty * 4 + i) * FF + fb * 128 + tx * 8) = o; }
    }
}
__device__ __forceinline__ void phase_moe_down_naive(Frame& F) {
    const bf16* act = (const bf16*)(F.ws + WS_ACT); const bf16* Wdn = (const bf16*)(F.ws + WS_WDN); bf16* y = (bf16*)(F.ws + WS_Y);
    const int* list = (const int*)(F.ws + WS_LIST);
    LAS int* mcnt = (LAS int*)(F.lds + 40960); LAS int* mbase = mcnt + 32;
    moe_map_build(F, mcnt, mbase);
    const int ty = F.tid >> 4, tx = F.tid & 15;
    int total = 0;
    for (int e = 0; e < NE; ++e) total += ((mcnt[e] + 127) / 128) * 8;
    for (int u = F.bid; u < total; u += F.G) {
        int e = 0, rem = u;
        for (; e < NE; ++e) { const int n = ((mcnt[e] + 127) / 128) * 8; if (rem < n) break; rem -= n; }
        const int rt = rem >> 3, ct = rem & 7;
        float acc[4][8]; ZERO_ACC(acc);
        naive_tile(F.lds, act + (size_t)(mbase[e] + rt * 128) * FF, FF, nullptr, Wdn + ((size_t)e * D + ct * 128) * FF, FF, FF, F.tid, acc);
#pragma unroll
        for (int i = 0; i < 4; ++i) { const int r = rt * 128 + ty * 4 + i;
            if (r < mcnt[e]) { const int ent = list[(size_t)e * LIST_CAP + r];
                v4u o; o.x = pk2(acc[i][0], acc[i][1]); o.y = pk2(acc[i][2], acc[i][3]); o.z = pk2(acc[i][4], acc[i][5]); o.w = pk2(acc[i][6], acc[i][7]);
                *(v4u*)(y + (size_t)ent * D + ct * 128 + tx * 8) = o; } }
    }
}


constexpr int MOE_OFF = 131072 + 1024;
constexpr int MOE_MAXU = 6;
template <bool GATHER> struct MoeSched {
    const LAS int* mtb; const LAS int* t2e; const LAS int* ent;
    int G, c, shift;
    const char* A; const char* W; size_t a_tile_stride, wexp_stride, wtile_stride;
    __device__ __forceinline__ bool next(int i, pg8::UnitG& u) const {
        const int L = i * G + c; if (i >= MOE_MAXU || L >= (mtb[32] << shift)) return false;
        const int T = L >> shift, ct = L & ((1 << shift) - 1), e = t2e[T];
        u.A = A + (GATHER ? (size_t)0 : (size_t)T * a_tile_stride); u.B = W + (size_t)e * wexp_stride + (size_t)ct * wtile_stride;
        u.id0 = T; u.id1 = ct; u.id2 = i; u.id3 = e; return true;
    }
    __device__ __forceinline__ unsigned row_of(const pg8::UnitG& u, int r) const {
        if (GATHER) { const int en = ent[u.id2 * 256 + r]; return (unsigned)((en < 0 ? 0 : en) >> 1); }
        return (unsigned)r;
    }
};
struct EpiUp {
    static constexpr bool PERM = true;
    bf16* act;
    __device__ __forceinline__ void operator()(const f32x4 (&acc)[2][2][4][2], const pg8::UnitG& u, int wr, int wc, int fr, int fq) const {
        const int row0 = u.id0 * 256 + wr * 64 + fr, col0 = u.id1 * 128 + wc * 32 + 8 * fq;
#pragma unroll
        for (int ai = 0; ai < 2; ++ai)
#pragma unroll
            for (int m = 0; m < 4; ++m) { float r8[8];
#pragma unroll
                for (int n = 0; n < 2; ++n)
#pragma unroll
                    for (int e = 0; e < 4; ++e) { const float g = acc[ai][0][m][n][e], uu = acc[ai][1][m][n][e]; r8[4 * n + e] = g * uu * __builtin_amdgcn_rcpf(1.0f + __expf(-g)); }
                v4u w; w.x = pg8::cvt_pk_bf16(r8[0], r8[1]); w.y = pg8::cvt_pk_bf16(r8[2], r8[3]); w.z = pg8::cvt_pk_bf16(r8[4], r8[5]); w.w = pg8::cvt_pk_bf16(r8[6], r8[7]);
                *(v4u*)(act + (size_t)(row0 + ai * 128 + m * 16) * FF + col0) = w; }
    }
};
struct EpiDown {
    static constexpr bool PERM = true;
    bf16* y; const LAS int* ent;
    __device__ __forceinline__ void operator()(const f32x4 (&acc)[2][2][4][2], const pg8::UnitG& u, int wr, int wc, int fr, int fq) const {
        const int col0 = u.id1 * 256 + wc * 32 + 8 * fq;
#pragma unroll
        for (int ai = 0; ai < 2; ++ai)
#pragma unroll
            for (int m = 0; m < 4; ++m) { const int en = ent[u.id2 * 256 + ai * 128 + wr * 64 + m * 16 + fr];
                if (en >= 0) { bf16* rowp = y + (size_t)en * D + col0;
#pragma unroll
                    for (int bj = 0; bj < 2; ++bj) { const f32x4 v0 = acc[ai][bj][m][0], v1 = acc[ai][bj][m][1];
                        v4u w; w.x = pg8::cvt_pk_bf16(v0[0], v0[1]); w.y = pg8::cvt_pk_bf16(v0[2], v0[3]); w.z = pg8::cvt_pk_bf16(v1[0], v1[1]); w.w = pg8::cvt_pk_bf16(v1[2], v1[3]);
                        *(v4u*)(rowp + bj * 128) = w; } }
                asm volatile("" ::: "memory"); }
    }
};
__device__ __forceinline__ void moe_tables(Frame& F, int shift) {
    LAS int* mcnt = (LAS int*)(F.lds + MOE_OFF); LAS int* mtb = mcnt + 32; LAS int* t2e = mcnt + 128; LAS int* ent = mcnt + 512;
    const unsigned* gcnt = (const unsigned*)(F.ws + WS_CTL) + CW_CNT; const int* list = (const int*)(F.ws + WS_LIST);
    __syncthreads();
    if (F.tid == 0) { int acc = 0;
        for (int e = 0; e < NE; ++e) { const int c = (int)gcnt[e]; mcnt[e] = c; mtb[e] = acc; const int nt = (c + 255) >> 8; for (int t = 0; t < nt; ++t) t2e[acc + t] = e; acc += nt; }
        mtb[32] = acc; }
    __syncthreads();
    const int total = mtb[32] << shift;
    for (int i = 0; i < MOE_MAXU; ++i) { const int L = i * F.G + F.bid; if (L >= total) break;
        const int T = L >> shift, e = t2e[T], rt = T - mtb[e];
        if (F.tid < 256) { const int row = rt * 256 + F.tid; ent[i * 256 + F.tid] = row < mcnt[e] ? list[(size_t)e * LIST_CAP + row] : -1; } }
    __syncthreads();
}
__device__ __forceinline__ void phase_moe_up_fast(Frame& F) {
    moe_tables(F, 1);
    const LAS int* mcnt = (const LAS int*)(F.lds + MOE_OFF);
    MoeSched<true> S{mcnt + 32, mcnt + 128, mcnt + 512, F.G, F.bid, 1, (const char*)(F.ws + WS_R2), (const char*)(F.ws + WS_WUP), 0, (size_t)512 * D * 2, (size_t)256 * D * 2};
    EpiUp E{(bf16*)(F.ws + WS_ACT)};
    pg8::gemm_phase<EpiUp, MoeSched<true>, true>(F.lds, D, S, E);
}
__device__ __forceinline__ void phase_moe_down_fast(Frame& F) {
    moe_tables(F, 2);
    const LAS int* mcnt = (const LAS int*)(F.lds + MOE_OFF);
    MoeSched<false> S{mcnt + 32, mcnt + 128, mcnt + 512, F.G, F.bid, 2, (const char*)(F.ws + WS_ACT), (const char*)(F.ws + WS_WDN), (size_t)256 * FF * 2, (size_t)D * FF * 2, (size_t)256 * FF * 2};
    EpiDown E{(bf16*)(F.ws + WS_Y), mcnt + 512};
    pg8::gemm_phase<EpiDown, MoeSched<false>, true>(F.lds, FF, S, E);
}

__device__ __forceinline__ void phase_final(Frame& F) {
    const float* mod = (const float*)(F.ws + WS_MOD); const bf16* y = (const bf16*)(F.ws + WS_Y); const float* tokw = (const float*)(F.ws + WS_TOKW);
    const int gw = F.bid * 8 + F.wave, NGW = F.G * 8;
    for (int m = gw; m < M; m += NGW) {
        const int b = m / SEQ; f32x4 v[4]; load_row16(F.out + (size_t)m * D, F.lane, v);
        const float w0 = tokw[(size_t)m * 2], w1 = tokw[(size_t)m * 2 + 1];
        f32x4 gt[4]; load_row16(mod + (size_t)b * NMOD + 5120, F.lane, gt);
        const v2u* y0 = (const v2u*)(y + (size_t)(2 * m) * D) + F.lane; const v2u* y1 = (const v2u*)(y + (size_t)(2 * m + 1) * D) + F.lane;
#pragma unroll
        for (int j = 0; j < 4; ++j) { const v2u a = y0[64 * j], c = y1[64 * j];
            f32x4 f; f.x = w0 * bflo(a.x) + w1 * bflo(c.x); f.y = w0 * bfhi(a.x) + w1 * bfhi(c.x); f.z = w0 * bflo(a.y) + w1 * bflo(c.y); f.w = w0 * bfhi(a.y) + w1 * bfhi(c.y);
            v[j] = v[j] + gt[j] * f; }
        const float r = 1.0f / sqrtf(wave_sum(sumsq16(v)) * (1.0f / D) + EPS);
        norm_mod16(v, r, INP(I_NFG), mod + (size_t)b * NMOD + 6144 + 1024, mod + (size_t)b * NMOD + 6144, F.lane);
        f32x4* orow = (f32x4*)(F.out + (size_t)m * D) + F.lane;
#pragma unroll
        for (int j = 0; j < 4; ++j) orow[64 * j] = v[j];
    }
}

constexpr int N_PHASES = 10;
__global__ void __launch_bounds__(512, 2) fwd(Args args) {
    extern __shared__ __attribute__((aligned(16))) unsigned char lds_raw[];
    Frame F;
    F.lds = (LAS unsigned char*)lds_raw;
    F.tid = threadIdx.x; F.lane = F.tid & 63; F.wave = __builtin_amdgcn_readfirstlane(F.tid >> 6);
    F.G = gridDim.x; F.bid = blockIdx.x;
    F.out = args.out; F.ws = args.ws;
    volatile LAS unsigned* MISC = (volatile LAS unsigned*)(F.lds + MISC_OFF);
    if (F.tid < 32) MISC[F.tid] = 0u;
    __syncthreads();
    unsigned* barw = (unsigned*)(F.ws + WS_CTL) + CW_BAR;
    const bool multi = (args.ph_hi - args.ph_lo) > 1;
    XcdBarrier bar; bar.bar = barw; bar.x = 0; bar.st = MISC + 8;
    if (multi) bar = xcd_barrier_post(barw, MISC + 8);
    const int lo = args.ph_lo, hi = args.ph_hi;
#ifdef ONLY_PHASE
#define IN(k) ((k) == ONLY_PHASE && lo <= (k) && (k) < hi)
#else
#define IN(k) (lo <= (k) && (k) < hi)
#endif
#define SEAM(k) do { if (IN(k) && IN((k) + 1)) xcd_barrier(bar); } while (0)
    if (IN(0)) { F.fresh(); phase_prologue(F); } SEAM(0);
    if (IN(1)) { F.fresh(); phase_norm1(F); } SEAM(1);
#if FAST_GEMM1
    if (IN(2)) { F.fresh(); phase_gemm1_fast(F); } SEAM(2);
#else
    if (IN(2)) { F.fresh(); phase_gemm1_naive(F); } SEAM(2);
#endif
#if FAST_SCAN
    if (IN(3)) { F.fresh(); phase_scan_fast(F); } SEAM(3);
#else
    if (IN(3)) { F.fresh(); phase_scan_naive(F); } SEAM(3);
#endif
#if FAST_GEMMO
    if (IN(4)) { F.fresh(); phase_gemm_out_fast(F); } SEAM(4);
#else
    if (IN(4)) { F.fresh(); phase_gemm_out_naive(F); } SEAM(4);
#endif
    if (IN(5)) { F.fresh(); phase_norm2_route(F); } SEAM(5);
#if FAST_MOE
    if (IN(6)) { F.fresh(); phase_moe_up_fast(F); } SEAM(6);
#else
    if (IN(6)) { F.fresh(); phase_moe_up_naive(F); } SEAM(6);
#endif
#if FAST_MOE
    if (IN(7)) { F.fresh(); phase_moe_down_fast(F); } SEAM(7);
#else
    if (IN(7)) { F.fresh(); phase_moe_down_naive(F); } SEAM(7);
#endif
    if (IN(8)) { F.fresh(); phase_final(F); }
#undef IN
#undef SEAM
}

#ifndef MK_N_LAUNCHES
#define MK_N_LAUNCHES 1
#endif
extern "C" void kernel_launch(void* const* d_in, const int* in_sizes, int n_in, void* d_out, int out_size, void* d_ws, size_t ws_size, hipStream_t stream) {
    static int grid = 0;
    if (grid == 0) {
        if (n_in != 23 || out_size != M * D || ws_size < WS_END) { fprintf(stderr, "kernel_launch: unexpected shapes (n_in %d out %d ws %zu)\n", n_in, out_size, ws_size); grid = -1; return; }
        int dev = 0, cus = 0, per_cu = 0;
        if (hipGetDevice(&dev) != hipSuccess || hipDeviceGetAttribute(&cus, hipDeviceAttributeMultiprocessorCount, dev) != hipSuccess) { grid = -1; return; }
        if (hipFuncSetAttribute((const void*)fwd, hipFuncAttributeMaxDynamicSharedMemorySize, LDS_BYTES) != hipSuccess) { fprintf(stderr, "kernel_launch: hipFuncSetAttribute failed\n"); grid = -1; return; }
        if (hipOccupancyMaxActiveBlocksPerMultiprocessor(&per_cu, (const void*)fwd, 512, LDS_BYTES) != hipSuccess || per_cu < 1) fprintf(stderr, "kernel_launch: occupancy query says %d\n", per_cu);
        (void)hipGetLastError();
        grid = cus;
    }
    if (grid < 0) return;
    (void)hipMemsetAsync((char*)d_ws + WS_CTL, 0, CTL_ZERO_BYTES, stream);
    Args a{};
    for (int i = 0; i < 23; ++i) a.in[i] = (const float*)d_in[i];
    a.out = (float*)d_out; a.ws = (unsigned char*)d_ws;
    if (MK_N_LAUNCHES == 1) { a.ph_lo = 0; a.ph_hi = N_PHASES; hipLaunchKernelGGL(fwd, dim3(grid), dim3(512), LDS_BYTES, stream, a); }
    else { for (int p = 0; p < 9; ++p) { a.ph_lo = p; a.ph_hi = p + 1; hipLaunchKernelGGL(fwd, dim3(grid), dim3(512), LDS_BYTES, stream, a); } }
}
```
